# Optimizing an MI355X kernel written in HIP

```python
import math, functools
import jax, jax.numpy as jnp
from jax import lax
import numpy as np

D_MODEL = 2048
BATCH = 4
SEQ = 2048
DEPTH = 1
DEC_BATCH = 128
DEC_SEQ = 1
PAST_LEN = 16384
PAGE_SIZE = 128

N_META = 16
CHUNK = 128
D_MIX = D_MODEL
D_SSM = D_MIX // 2
D_RET = D_MIX - D_SSM
SSM_HEADDIM = 64
SSM_HEADS = D_SSM // SSM_HEADDIM
SSM_GROUPS = 2
HEADS_PER_GROUP = SSM_HEADS // SSM_GROUPS
D_STATE = 128
CONV_W = 4
CONV_DIM = D_SSM + 2 * SSM_GROUPS * D_STATE
RET_HEADS = 4
RET_HEADDIM = D_RET // RET_HEADS
ROPE_BASE = 10000.0
D_FF = -(-(8 * D_MODEL) // (3 * 256)) * 256
PROJ_SPLITS = (D_SSM, D_SSM + CONV_DIM, D_SSM + CONV_DIM + SSM_HEADS,
               D_SSM + CONV_DIM + SSM_HEADS + D_RET,
               D_SSM + CONV_DIM + SSM_HEADS + 2 * D_RET,
               D_SSM + CONV_DIM + SSM_HEADS + 3 * D_RET)
PROJ_DIM = D_SSM + CONV_DIM + SSM_HEADS + 4 * D_RET
EPS = 1e-6

kernel_name = 'hymba_ssd_retention_step'


def normalize(x):
    xf = x.astype(jnp.float32)
    return xf * lax.rsqrt(jnp.mean(xf * xf, axis=-1, keepdims=True) + EPS)


def rmsnorm(x, g):
    return (normalize(x) * g.astype(jnp.float32)).astype(x.dtype)


def rotary(x, pos):
    half = x.shape[-1] // 2
    inv_freq = ROPE_BASE ** (-jnp.arange(half, dtype=jnp.float32) / half)
    ang = (pos[:, None] * inv_freq[None, :])[:, None, :]
    cos, sin = jnp.cos(ang), jnp.sin(ang)
    x1, x2 = x[..., :half], x[..., half:]
    return jnp.concatenate([x1 * cos - x2 * sin, x1 * sin + x2 * cos], axis=-1)


def causal_conv(xbc, buf, w, b):
    l = xbc.shape[1]
    full = jnp.concatenate([buf, xbc], axis=1)
    out = b
    for i in range(CONV_W):
        out = out + full[:, i:i + l] * w[i]
    return jax.nn.silu(out), full[:, l:]


def scan_chunks(step, state, xs, chunk):
    b, L = xs[0].shape[:2]
    n = L // chunk
    def split(a):
        return jnp.moveaxis(a.reshape(b, n, chunk, *a.shape[2:]), 1, 0)
    state, ys = lax.scan(step, state, tuple(split(a) for a in xs))
    ys = jnp.moveaxis(ys, 0, 1).reshape(b, L, *ys.shape[3:])
    return state, ys


def ssd_chunk(a_neg, h, inp):
    x, dt, bm, cm = inp
    b, c = x.shape[:2]
    x = x.reshape(b, c, SSM_GROUPS, HEADS_PER_GROUP, SSM_HEADDIM)
    dtg = dt.reshape(b, c, SSM_GROUPS, HEADS_PER_GROUP)
    hg = h.reshape(b, SSM_GROUPS, HEADS_PER_GROUP, SSM_HEADDIM, D_STATE)
    lcum = jnp.cumsum(dtg * a_neg.reshape(SSM_GROUPS, HEADS_PER_GROUP), axis=1)
    causal = jnp.tril(jnp.ones((c, c), dtype=bool))
    seg = lcum[:, :, None] - lcum[:, None, :]
    decay = jnp.exp(jnp.where(causal[None, :, :, None, None], seg, -jnp.inf))
    cb = jnp.einsum('bign,bjgn->bijg', cm, bm)
    w = cb[..., None] * decay * dtg[:, None]
    y = jnp.einsum('bijgh,bjghp->bighp', w, x)
    y = y + jnp.einsum('bign,bghpn->bighp', cm, hg) * jnp.exp(lcum)[..., None]
    last = lcum[:, -1]
    wts = jnp.exp(last[:, None] - lcum) * dtg
    hg = jnp.exp(last)[..., None, None] * hg + jnp.einsum('bjgh,bjgn,bjghp->bghpn', wts, bm, x)
    return hg.reshape(b, SSM_HEADS, SSM_HEADDIM, D_STATE), y.reshape(b, c, SSM_HEADS, SSM_HEADDIM)


def retention_chunk(s, inp):
    q, k, v = inp
    c = q.shape[1]
    lg = jnp.log1p(-(2.0 ** (-5.0 - jnp.arange(RET_HEADS, dtype=jnp.float32))))
    idx = jnp.arange(c, dtype=jnp.float32)
    diff = idx[:, None] - idx[None, :]
    decay = jnp.where((diff >= 0)[..., None], jnp.exp(jnp.maximum(diff, 0.0)[..., None] * lg), 0.0)
    scores = jnp.einsum('bihd,bjhd->bijh', q, k) * decay
    y = jnp.einsum('bijh,bjhv->bihv', scores, v)
    y = y + jnp.einsum('bihd,bhdv->bihv', q, s) * jnp.exp((idx + 1.0)[:, None] * lg)[..., None]
    wk = jnp.exp((c - 1.0 - idx)[:, None] * lg)
    s = jnp.exp(c * lg)[:, None, None] * s + jnp.einsum('bjhd,bjhv->bhdv', k * wk[..., None], v)
    return s, y


def mixers(u, pos, conv_buf, ssm_h, ret_s, segments, w_in, conv_w, conv_b, dt_bias, a_log, d_skip, ssm_norm_g, ret_norm_g):
    b, l, _ = u.shape
    f32 = jnp.float32
    proj = (u @ w_in).astype(f32)
    z, xbc, dt_raw, q, k, v, g = jnp.split(proj, PROJ_SPLITS, axis=-1)
    xbc, new_conv = causal_conv(xbc, conv_buf.astype(f32), conv_w.astype(f32), conv_b.astype(f32))
    xs, bm, cm = jnp.split(xbc, (D_SSM, D_SSM + SSM_GROUPS * D_STATE), axis=-1)
    xs = xs.reshape(b, l, SSM_HEADS, SSM_HEADDIM)
    bm = bm.reshape(b, l, SSM_GROUPS, D_STATE)
    cm = cm.reshape(b, l, SSM_GROUPS, D_STATE)
    dt = jax.nn.softplus(dt_raw + dt_bias.astype(f32))
    a_neg = -jnp.exp(a_log.astype(f32))
    q = rotary(q.reshape(b, l, RET_HEADS, RET_HEADDIM), pos)
    k = rotary(k.reshape(b, l, RET_HEADS, RET_HEADDIM), pos) * (RET_HEADDIM ** -0.5)
    v = v.reshape(b, l, RET_HEADS, RET_HEADDIM)
    ssm_h = ssm_h.astype(f32)
    ret_s = ret_s.astype(f32)
    ssd_step = functools.partial(ssd_chunk, a_neg)
    y_ssm, y_ret = [], []
    start = 0
    for length, chunk in segments:
        sl = slice(start, start + length)
        ssm_h, ys = scan_chunks(ssd_step, ssm_h, (xs[:, sl], dt[:, sl], bm[:, sl], cm[:, sl]), chunk)
        ret_s, yr = scan_chunks(retention_chunk, ret_s, (q[:, sl], k[:, sl], v[:, sl]), chunk)
        y_ssm.append(ys)
        y_ret.append(yr)
        start += length
    y1 = jnp.concatenate(y_ssm, axis=1) + d_skip.astype(f32)[:, None] * xs
    y1 = (y1.reshape(b, l, D_SSM) * jax.nn.silu(z)).reshape(b, l, SSM_GROUPS, D_SSM // SSM_GROUPS)
    y1 = normalize(y1).reshape(b, l, D_SSM) * ssm_norm_g.astype(f32)
    y2 = normalize(jnp.concatenate(y_ret, axis=1)).reshape(b, l, D_RET) * ret_norm_g.astype(f32) * jax.nn.silu(g)
    mix = jnp.concatenate([y1, y2], axis=-1).astype(u.dtype)
    return mix, new_conv, ssm_h, ret_s


def layer(h, pos, conv_buf, ssm_h, ret_s, segments, pre_mix_g, post_mix_g, pre_ffn_g, post_ffn_g,
          w_in, conv_w, conv_b, dt_bias, a_log, d_skip, ssm_norm_g, ret_norm_g, w_out, w_gate, w_up, w_down):
    u = rmsnorm(h, pre_mix_g)
    mix, conv_buf, ssm_h, ret_s = mixers(u, pos, conv_buf, ssm_h, ret_s, segments, w_in, conv_w, conv_b,
                                         dt_bias, a_log, d_skip, ssm_norm_g, ret_norm_g)
    h = h + rmsnorm(mix @ w_out, post_mix_g)
    f = rmsnorm(h, pre_ffn_g)
    f = (jax.nn.silu(f @ w_gate) * (f @ w_up)) @ w_down
    h = h + rmsnorm(f, post_ffn_g)
    return h, conv_buf, ssm_h, ret_s


def setup_inputs(seed: int = 0) -> dict:
    key = jax.random.key(seed)
    ks = jax.random.split(key, 24)
    f32 = jnp.float32
    def nrm(k, shape, scale):
        return jax.random.normal(k, shape, f32) * scale
    def gain(k, shape):
        return 1.0 + 0.05 * jax.random.normal(k, shape, f32)
    dt0 = jnp.exp(jax.random.uniform(ks[14], (DEPTH, SSM_HEADS), f32, math.log(1e-3), math.log(1e-1)))
    dt_bias = dt0 + jnp.log(-jnp.expm1(-dt0))
    return dict(
        x_prompt=nrm(ks[0], (BATCH, SEQ, D_MODEL), 1.0),
        x_sample=nrm(ks[1], (DEC_BATCH, DEC_SEQ, D_MODEL), 1.0),
        state_conv=nrm(ks[2], (DEPTH, DEC_BATCH, CONV_W - 1, CONV_DIM), 1.0),
        state_ssm=nrm(ks[3], (DEPTH, DEC_BATCH, SSM_HEADS, SSM_HEADDIM, D_STATE), 0.5),
        state_ret=nrm(ks[4], (DEPTH, DEC_BATCH, RET_HEADS, RET_HEADDIM, RET_HEADDIM), 0.5),
        meta_tokens=nrm(ks[5], (N_META, D_MODEL), 1.0),
        pre_mix_g=gain(ks[6], (DEPTH, D_MODEL)),
        post_mix_g=gain(ks[7], (DEPTH, D_MODEL)),
        pre_ffn_g=gain(ks[8], (DEPTH, D_MODEL)),
        post_ffn_g=gain(ks[9], (DEPTH, D_MODEL)),
        w_in=nrm(ks[10], (DEPTH, D_MODEL, PROJ_DIM), D_MODEL ** -0.5),
        conv_w=nrm(ks[11], (DEPTH, CONV_W, CONV_DIM), CONV_W ** -0.5),
        conv_b=nrm(ks[12], (DEPTH, CONV_DIM), 0.02),
        dt_bias=dt_bias,
        a_log=jnp.log(jax.random.uniform(ks[13], (DEPTH, SSM_HEADS), f32, 1.0, 16.0)),
        d_skip=gain(ks[15], (DEPTH, SSM_HEADS)),
        ssm_norm_g=gain(ks[16], (DEPTH, D_SSM)),
        ret_norm_g=gain(ks[17], (DEPTH, D_RET)),
        w_out=nrm(ks[18], (DEPTH, D_MIX, D_MODEL), D_MIX ** -0.5),
        w_gate=nrm(ks[19], (DEPTH, D_MODEL, D_FF), D_MODEL ** -0.5),
        w_up=nrm(ks[20], (DEPTH, D_MODEL, D_FF), D_MODEL ** -0.5),
        w_down=nrm(ks[21], (DEPTH, D_FF, D_MODEL), D_FF ** -0.5),
    )


def reference(x_prompt, x_sample, state_conv, state_ssm, state_ret, meta_tokens, pre_mix_g, post_mix_g,
              pre_ffn_g, post_ffn_g, w_in, conv_w, conv_b, dt_bias, a_log, d_skip, ssm_norm_g, ret_norm_g,
              w_out, w_gate, w_up, w_down):
    f32 = jnp.float32
    bp, seq = x_prompt.shape[:2]
    bs, dec_seq = x_sample.shape[:2]
    hp = jnp.concatenate([jnp.broadcast_to(meta_tokens[None].astype(x_prompt.dtype), (bp, N_META, D_MODEL)),
                          x_prompt], axis=1)
    pos_p = jnp.arange(N_META + seq, dtype=f32)
    seg_p = ((N_META, N_META), (seq, CHUNK))
    hs = x_sample
    pos_s = PAST_LEN + jnp.arange(dec_seq, dtype=f32)
    dec_chunk = CHUNK if dec_seq % CHUNK == 0 else dec_seq
    seg_s = ((dec_seq, dec_chunk),)
    p_conv, p_ssm, p_ret, s_conv, s_ssm, s_ret = [], [], [], [], [], []
    for i in range(DEPTH):
        lp = (pre_mix_g[i], post_mix_g[i], pre_ffn_g[i], post_ffn_g[i], w_in[i], conv_w[i], conv_b[i],
              dt_bias[i], a_log[i], d_skip[i], ssm_norm_g[i], ret_norm_g[i], w_out[i], w_gate[i], w_up[i], w_down[i])
        hp, c, s, r = layer(hp, pos_p,
                            jnp.zeros((bp, CONV_W - 1, CONV_DIM), f32),
                            jnp.zeros((bp, SSM_HEADS, SSM_HEADDIM, D_STATE), f32),
                            jnp.zeros((bp, RET_HEADS, RET_HEADDIM, RET_HEADDIM), f32),
                            seg_p, *lp)
        p_conv.append(c); p_ssm.append(s); p_ret.append(r)
        hs, c, s, r = layer(hs, pos_s, state_conv[i], state_ssm[i], state_ret[i], seg_s, *lp)
        s_conv.append(c); s_ssm.append(s); s_ret.append(r)
    y_prompt = hp[:, N_META:]
    y_sample = hs
    prompt_conv = jnp.stack(p_conv)
    prompt_ssm = jnp.stack(p_ssm)
    prompt_ret = jnp.stack(p_ret)
    sample_conv = jnp.stack(s_conv)
    sample_ssm = jnp.stack(s_ssm)
    sample_ret = jnp.stack(s_ret)
    return (y_prompt, y_sample, prompt_conv, prompt_ssm, prompt_ret, sample_conv, sample_ssm, sample_ret)
```

```cpp
#include <hip/hip_runtime.h>
#include <hip/hip_cooperative_groups.h>
#include <cstdio>
#include <cmath>
#include <cstring>
namespace cg = cooperative_groups;

#ifndef COOP_LAUNCH
#define COOP_LAUNCH 1
#endif

#define LAS __attribute__((address_space(3)))
typedef unsigned short bf16_t;
typedef short bf16x8 __attribute__((ext_vector_type(8)));
typedef float f32x4 __attribute__((ext_vector_type(4)));
typedef unsigned u32x4 __attribute__((ext_vector_type(4)));
typedef unsigned u32x2 __attribute__((ext_vector_type(2)));

constexpr int DM = 2048, NBATCH = 4, SEQL = 2048, NMETA = 16, LP = SEQL + NMETA, DECB = 128;
constexpr int MMAIN = NBATCH * SEQL;
constexpr int SROW0 = MMAIN;
constexpr int MROW0 = SROW0 + DECB;
constexpr int MTOT = MROW0 + NMETA;
constexpr int MOUT = MROW0;
constexpr int MPAD = 8448;
constexpr int CONVD = 1536, DFF = 5632, PROJD = 6672, PROJP = 6912;
constexpr int OZ = 0, OX = 1024, OB = 2048, OC = 2304, ODT = 2560, OQ = 2576, OKK = 3600, OV = 4624, OG = 5648;
constexpr int NSTEP = 33;
constexpr int TABROWS = LP + 1;
constexpr float EPS = 1e-6f;

constexpr size_t WS_WIN = 0;
constexpr size_t WS_WOUT = WS_WIN + (size_t)PROJP * DM * 2;
constexpr size_t WS_WGU = WS_WOUT + (size_t)DM * DM * 2;
constexpr size_t WS_WDN = WS_WGU + (size_t)2 * DFF * DM * 2;
constexpr size_t WS_ABUF = WS_WDN + (size_t)DM * DFF * 2;
constexpr size_t WS_PROJ = WS_ABUF + (size_t)MPAD * DM * 2;
constexpr size_t WS_TMP = WS_PROJ + (size_t)MPAD * PROJP * 2;
constexpr size_t WS_H1 = WS_TMP + (size_t)MPAD * DM * 4;
constexpr size_t WS_TAB = WS_H1 + (size_t)MPAD * DM * 4;
constexpr size_t WS_XC = WS_TAB + (size_t)TABROWS * 256 * 4;
constexpr size_t WS_AUX2 = WS_XC + (size_t)MPAD * CONVD * 2;
constexpr size_t WS_BAR = WS_AUX2 + (size_t)2 * DECB * DM * 4;
constexpr size_t WS_END = WS_BAR + 16384;

constexpr size_t O_YP = 0;
constexpr size_t O_YS = O_YP + (size_t)NBATCH * SEQL * DM;
constexpr size_t O_PCONV = O_YS + (size_t)DECB * DM;
constexpr size_t O_PSSM = O_PCONV + (size_t)NBATCH * 3 * CONVD;
constexpr size_t O_PRET = O_PSSM + (size_t)NBATCH * 16 * 64 * 128;
constexpr size_t O_SCONV = O_PRET + (size_t)NBATCH * 4 * 256 * 256;
constexpr size_t O_SSSM = O_SCONV + (size_t)DECB * 3 * CONVD;
constexpr size_t O_SRET = O_SSSM + (size_t)DECB * 16 * 64 * 128;
constexpr size_t O_END = O_SRET + (size_t)DECB * 4 * 256 * 256;

constexpr int LDS_ST = 135168;
constexpr int LDS_BYTES = LDS_ST + 16;
constexpr int NPHASE = 10;

struct Params {
    const float *x_prompt, *x_sample, *state_conv, *state_ssm, *state_ret, *meta, *pre_mix_g, *post_mix_g, *pre_ffn_g, *post_ffn_g,
        *w_in, *conv_w, *conv_b, *dt_bias, *a_log, *d_skip, *ssm_norm_g, *ret_norm_g, *w_out, *w_gate, *w_up, *w_down;
    float* out;
    unsigned char* ws;
    float lg0, lg1, lg2, lg3;
    int ph_lo, ph_hi, coop, pad;
};

__device__ __forceinline__ float bf2f(bf16_t b) { return __uint_as_float(((unsigned)b) << 16); }
typedef __bf16 nbf16x2 __attribute__((ext_vector_type(2)));
typedef float f32x2n __attribute__((ext_vector_type(2)));
__device__ __forceinline__ bf16_t f2bf(float f) { const __bf16 h = (__bf16)f; return __builtin_bit_cast(unsigned short, h); }
__device__ __forceinline__ unsigned pack2(float a, float b) { const f32x2n v = {a, b}; const nbf16x2 h = __builtin_convertvector(v, nbf16x2); return __builtin_bit_cast(unsigned, h); }
__device__ __forceinline__ float lo16(unsigned u) { return __uint_as_float(u << 16); }
__device__ __forceinline__ float hi16(unsigned u) { return __uint_as_float(u & 0xffff0000u); }
__device__ __forceinline__ float4 ld4bf(const bf16_t* p) { const u32x2 u = *(const u32x2*)p; return make_float4(lo16(u.x), hi16(u.x), lo16(u.y), hi16(u.y)); }
__device__ __forceinline__ float silu_f(float x) { return x * __builtin_amdgcn_rcpf(1.0f + __expf(-x)); }
__device__ __forceinline__ float softplus_f(float x) { return fmaxf(x, 0.0f) + log1pf(__expf(-fabsf(x))); }
__device__ __forceinline__ float wave_sum(float v) {
    v += __int_as_float(__builtin_amdgcn_update_dpp(0, __float_as_int(v), 0xB1, 0xF, 0xF, true));
    v += __int_as_float(__builtin_amdgcn_update_dpp(0, __float_as_int(v), 0x4E, 0xF, 0xF, true));
    v += __int_as_float(__builtin_amdgcn_update_dpp(0, __float_as_int(v), 0x141, 0xF, 0xF, true));
    v += __int_as_float(__builtin_amdgcn_update_dpp(0, __float_as_int(v), 0x140, 0xF, 0xF, true));
    const int iv = __float_as_int(v);
    return (__int_as_float(__builtin_amdgcn_readlane(iv, 0)) + __int_as_float(__builtin_amdgcn_readlane(iv, 16)))
         + (__int_as_float(__builtin_amdgcn_readlane(iv, 32)) + __int_as_float(__builtin_amdgcn_readlane(iv, 48)));
}
__device__ __forceinline__ void lds_barrier() { asm volatile("s_waitcnt lgkmcnt(0)\n\ts_barrier" ::: "memory"); }
__device__ __forceinline__ unsigned cvt_pk_bf16(float lo, float hi) { unsigned r; asm volatile("v_cvt_pk_bf16_f32 %0, %1, %2" : "=v"(r) : "v"(lo), "v"(hi)); return r; }

__device__ __forceinline__ const float* src_row(const Params& p, int row) {
    if (row < MMAIN) return p.x_prompt + (size_t)row * DM;
    if (row < MROW0) return p.x_sample + (size_t)(row - SROW0) * DM;
    return p.meta + (size_t)(row - MROW0) * DM;
}
__device__ __forceinline__ int prow(int b, int t) { return t < NMETA ? MROW0 + t : b * SEQL + t - NMETA; }

template <int K>
__device__ __forceinline__ void mma16(f32x4& acc, const LAS bf16_t* A, int lda, const LAS bf16_t* Bt, int ldb, int fr, int fq) {
    const LAS bf16_t* ap = A + fr * lda + fq * 8; const LAS bf16_t* bp = Bt + fr * ldb + fq * 8;
#pragma unroll 1
    for (int k0 = 0; k0 < K; k0 += 64) {
#pragma unroll
        for (int k1 = 0; k1 < 64; k1 += 32) {
            const bf16x8 a = *(const LAS bf16x8*)(ap + k0 + k1);
            const bf16x8 b = *(const LAS bf16x8*)(bp + k0 + k1);
            acc = __builtin_amdgcn_mfma_f32_16x16x32_bf16(a, b, acc, 0, 0, 0);
        }
    }
}

template <int K>
__device__ __forceinline__ void mma16x3(f32x4& c0, f32x4& c1, f32x4& c2, const LAS bf16_t* A, const LAS bf16_t* B0, const LAS bf16_t* B1, const LAS bf16_t* B2, int ld, int fr, int fq) {
    const int off = fr * ld + fq * 8;
    const LAS bf16_t* ap = A + off; const LAS bf16_t* p0 = B0 + off; const LAS bf16_t* p1 = B1 + off; const LAS bf16_t* p2 = B2 + off;
#pragma unroll 1
    for (int k0 = 0; k0 < K; k0 += 128) {
#pragma unroll
        for (int k1 = 0; k1 < 128; k1 += 32) {
            const bf16x8 a = *(const LAS bf16x8*)(ap + k0 + k1);
            const bf16x8 x0 = *(const LAS bf16x8*)(p0 + k0 + k1), x1 = *(const LAS bf16x8*)(p1 + k0 + k1), x2 = *(const LAS bf16x8*)(p2 + k0 + k1);
            c0 = __builtin_amdgcn_mfma_f32_16x16x32_bf16(a, x0, c0, 0, 0, 0);
            c1 = __builtin_amdgcn_mfma_f32_16x16x32_bf16(a, x1, c1, 0, 0, 0);
            c2 = __builtin_amdgcn_mfma_f32_16x16x32_bf16(a, x2, c2, 0, 0, 0);
        }
    }
}
typedef short s16x4 __attribute__((ext_vector_type(4)));
__device__ __forceinline__ bf16x8 ld_row(const LAS bf16_t* M, int ld, int k0, int fr, int fq) { return *(const LAS bf16x8*)(M + fr * ld + k0 + fq * 8); }
__device__ __forceinline__ bf16x8 ld_tr(const LAS bf16_t* M, int ld, int k0, int fr, int fq) {
    const LAS bf16_t* a = M + (k0 + 8 * fq + (fr >> 2)) * ld + 4 * (fr & 3);
    const s16x4 lo = __builtin_amdgcn_ds_read_tr16_b64_v4i16((LAS s16x4*)a);
    const s16x4 hi = __builtin_amdgcn_ds_read_tr16_b64_v4i16((LAS s16x4*)(a + 4 * ld));
    return (bf16x8){lo[0], lo[1], lo[2], lo[3], hi[0], hi[1], hi[2], hi[3]};
}
#define MFMA16(a, b, c) __builtin_amdgcn_mfma_f32_16x16x32_bf16(a, b, c, 0, 0, 0)

#define XB_TMO      128
#define XB_XCNT(j)  (256  + 64 * (j))
#define XB_XSUB(j)  (1280 + 64 * (j))
#define XB_XGEN(j)  (2304 + 64 * (j))
#define XB_TOP      3328
#define XB_TOPGEN   3392
#define XCD_BAR_WORDS 3456
#define XB_SPIN_CAP (1u << 18)
__device__ __forceinline__ unsigned xb_ld(unsigned* p)              { return __hip_atomic_load(p, __ATOMIC_RELAXED, __HIP_MEMORY_SCOPE_AGENT); }
__device__ __forceinline__ unsigned xb_add(unsigned* p, unsigned v) { return __hip_atomic_fetch_add(p, v, __ATOMIC_RELAXED, __HIP_MEMORY_SCOPE_AGENT); }
__device__ __forceinline__ unsigned xb_xcc_id() { return (unsigned)__builtin_amdgcn_s_getreg((3 << 11) | 20) & 0xFu; }
#define XB_SPIN(cond, bar) do { unsigned _sp = 0; while (cond) { __builtin_amdgcn_s_sleep(1); \
    if ((++_sp & 255u) == 0u) { if (xb_ld(&(bar)[XB_TMO])) break; if (_sp > XB_SPIN_CAP) { atomicAdd(&(bar)[XB_TMO], 1u); break; } } } } while (0)
struct XcdBarrier { unsigned* bar; unsigned x; volatile LAS unsigned* st; };
__device__ __forceinline__ XcdBarrier xcd_barrier_post(unsigned* bar, volatile LAS unsigned* st) {
    XcdBarrier b; b.bar = bar; b.x = xb_xcc_id(); b.st = st;
    if (threadIdx.x == 0) (void)xb_add(&bar[XB_XCNT(b.x)], 1u);
    return b;
}
__device__ __forceinline__ void xcd_barrier_complete(unsigned* bar, unsigned x, unsigned& nloc, unsigned& nx) {
    const unsigned G = gridDim.x * gridDim.y * gridDim.z;
    unsigned sum, cnt, mine, sp = 0u;
    for (;;) {
        sum = 0u; cnt = 0u; mine = 0u;
#pragma unroll
        for (unsigned j = 0; j < 16; ++j) { const unsigned c = xb_ld(&bar[XB_XCNT(j)]); sum += c; cnt += (c > 0u) ? 1u : 0u; mine = (j == x) ? c : mine; }
        if (sum == G) break;
        __builtin_amdgcn_s_sleep(1);
        if ((++sp & 255u) == 0u) { if (xb_ld(&bar[XB_TMO])) break; if (sp > XB_SPIN_CAP) { atomicAdd(&bar[XB_TMO], 1u); break; } }
    }
    nloc = mine > 0u ? mine : 1u; nx = cnt > 0u ? cnt : 1u;
}
__device__ __forceinline__ void xcd_barrier(const XcdBarrier& b) {
    asm volatile("s_waitcnt vmcnt(0)" ::: "memory");
    __syncthreads();
    if (threadIdx.x == 0) {
        unsigned* bar = b.bar;
        __builtin_amdgcn_s_waitcnt(0);
        unsigned nloc = b.st[0], nx = b.st[1];
        if (nloc == 0u) { xcd_barrier_complete(bar, b.x, nloc, nx); b.st[0] = nloc; b.st[1] = nx; }
        const unsigned old = xb_add(&bar[XB_XSUB(b.x)], 1u);
        const unsigned gen = old / nloc;
        if (old + 1u == (gen + 1u) * nloc) {
            __builtin_amdgcn_fence(__ATOMIC_RELEASE, "agent");
            asm volatile("s_waitcnt vmcnt(0)" ::: "memory");
            const unsigned og = xb_add(&bar[XB_TOP], 1u);
            const unsigned tg = og / nx;
            if (og + 1u == (tg + 1u) * nx) xb_add(&bar[XB_TOPGEN], 1u);
            else XB_SPIN(xb_ld(&bar[XB_TOPGEN]) == tg, bar);
            __builtin_amdgcn_fence(__ATOMIC_ACQUIRE, "agent");
            xb_add(&bar[XB_XGEN(b.x)], 1u);
            asm volatile("s_waitcnt vmcnt(0)" ::: "memory");
        } else {
            XB_SPIN(xb_ld(&bar[XB_XGEN(b.x)]) == gen, bar);
            __builtin_amdgcn_fence(__ATOMIC_ACQUIRE, "agent");
            asm volatile("s_waitcnt vmcnt(0)" ::: "memory");
        }
    }
    __syncthreads();
}

namespace pg8 {
constexpr int BM = 256, BK = 64, HALF = 128, HTB = HALF * BK * 2, STAGE_BYTES = 8 * HTB, NXCD = 8, WGM = 8;
__host__ __device__ __forceinline__ int lds_byte(int r, int c) { const int st = (r >> 4) * 2 + (c >> 5), rr = r & 15, cc = c & 31, ob = rr * 64 + cc * 2; return st * 1024 + (ob ^ (((ob >> 9) & 1) << 5)); }
__host__ __device__ __forceinline__ void stage_rc(int b, int& R, int& C) { const int st = b / 1024, sb = b % 1024, swz = sb ^ (((sb >> 9) & 1) << 5); R = (st >> 1) * 16 + swz / 64; C = (st & 1) * 32 + (swz % 64) / 2; }
__host__ __device__ __forceinline__ int perm32(int rho) { const int n = rho >> 4, i = rho & 15; return 8 * (i >> 2) + 4 * n + (i & 3); }
struct Unit { int pm, pn; };
struct Gemm { const bf16_t* A; const bf16_t* Bt; int M, N, K; };
struct StaticOrder {
    int nM, nN, nwg, G, c;
    __host__ __device__ void init(int M, int N, int G_, int c_) { nM = M / BM; nN = N / BM; nwg = nM * nN; G = G_; c = c_; }
    __host__ __device__ bool next(int i, Unit& u) const {
        const long L = (long)i * G + c; if (L >= nwg) return false;
        int wgid = (int)L; { const int q = nwg / NXCD, r = nwg % NXCD, xcd = wgid % NXCD, off = wgid / NXCD; wgid = (xcd < r ? xcd * (q + 1) : r * (q + 1) + (xcd - r) * q) + off; }
        const int nig = WGM * nN, gid = wgid / nig, fm = gid * WGM, gsz = (nM - fm) < WGM ? (nM - fm) : WGM;
        u.pm = fm + ((wgid % nig) % gsz); u.pn = (wgid % nig) / gsz; return true;
    }
};

struct EpiF32 {
    static constexpr bool PERM = false;
    float* C; int ldc;
    __device__ __forceinline__ void operator()(const f32x4 (&acc)[2][2][4][2], const Unit& u, int wr, int wc, int fr, int fq) const {
        const int row0 = u.pm * BM + wr * 64 + fr, col0 = u.pn * BM + wc * 32 + 4 * fq;
#pragma unroll
        for (int ai = 0; ai < 2; ++ai)
#pragma unroll
            for (int m = 0; m < 4; ++m) { float* rowp = C + (size_t)(row0 + ai * HALF + m * 16) * ldc + col0;
#pragma unroll
                for (int bj = 0; bj < 2; ++bj)
#pragma unroll
                    for (int n = 0; n < 2; ++n) *(f32x4*)(rowp + bj * HALF + n * 16) = acc[ai][bj][m][n]; }
    }
};
struct EpiBf16 {
    static constexpr bool PERM = true;
    bf16_t* O; int ldc;
    __device__ __forceinline__ void operator()(const f32x4 (&acc)[2][2][4][2], const Unit& u, int wr, int wc, int fr, int fq) const {
        const int row0 = u.pm * BM + wr * 64 + fr, col0 = u.pn * BM + wc * 32 + 8 * fq;
#pragma unroll
        for (int ai = 0; ai < 2; ++ai)
#pragma unroll
            for (int m = 0; m < 4; ++m) { bf16_t* rowp = O + (size_t)(row0 + ai * HALF + m * 16) * ldc + col0;
#pragma unroll
                for (int bj = 0; bj < 2; ++bj) { const f32x4 v0 = acc[ai][bj][m][0], v1 = acc[ai][bj][m][1];
                    u32x4 w; w.x = cvt_pk_bf16(v0[0], v0[1]); w.y = cvt_pk_bf16(v0[2], v0[3]); w.z = cvt_pk_bf16(v1[0], v1[1]); w.w = cvt_pk_bf16(v1[2], v1[3]);
                    *(u32x4*)(rowp + bj * HALF) = w; } }
    }
};
struct EpiSwiGLU {
    static constexpr bool PERM = true;
    bf16_t* O; int ldc;
    __device__ __forceinline__ void operator()(const f32x4 (&acc)[2][2][4][2], const Unit& u, int wr, int wc, int fr, int fq) const {
        const int row0 = u.pm * BM + wr * 64 + fr, col0 = u.pn * HALF + wc * 32 + 8 * fq;
#pragma unroll
        for (int ai = 0; ai < 2; ++ai)
#pragma unroll
            for (int m = 0; m < 4; ++m) { bf16_t* rowp = O + (size_t)(row0 + ai * HALF + m * 16) * ldc + col0;
                float o[8];
#pragma unroll
                for (int n = 0; n < 2; ++n)
#pragma unroll
                    for (int j = 0; j < 4; ++j) { const float g = acc[ai][0][m][n][j], up = acc[ai][1][m][n][j]; o[n * 4 + j] = g * __builtin_amdgcn_rcpf(1.0f + __expf(-g)) * up; }
                u32x4 w; w.x = cvt_pk_bf16(o[0], o[1]); w.y = cvt_pk_bf16(o[2], o[3]); w.z = cvt_pk_bf16(o[4], o[5]); w.w = cvt_pk_bf16(o[6], o[7]);
                *(u32x4*)(rowp) = w; }
    }
};

template <class Epi, class Sched>
__device__ __forceinline__ void gemm_phase(LAS unsigned char* lds, const Gemm g, const Sched& S, const Epi& E) {
    const int tid = threadIdx.x, wid = __builtin_amdgcn_readfirstlane(tid >> 6), lane = tid & 63, wr = wid >> 2, wc = wid & 3, fr = lane & 15, fq = lane >> 4;
    const int K = g.K, nt = K / BK;
    unsigned voffA[2], voffB[2];
#pragma unroll
    for (int i = 0; i < 2; ++i) { int R, C; stage_rc(tid * 16 + i * 8192, R, C); const int Rb = Epi::PERM ? ((R & ~31) + perm32(R & 31)) : R;
        voffA[i] = (unsigned)(R * K + C) * 2u; voffB[i] = (unsigned)(Rb * K + C) * 2u; }
    const size_t kstep = (size_t)(BK * 2);
    const size_t hstep = (size_t)HALF * K * 2;
    const size_t tstep = 2 * hstep;
    const unsigned ldsw = (unsigned)wid * 1024u;
    const int aoff = lds_byte(wr * 64 + fr, fq * 8), boff = lds_byte(wc * 32 + fr, fq * 8);
#define PG8_SA(b, h) (((b) * 2 + (h)) * HTB)
#define PG8_SB(b, h) ((4 + (b) * 2 + (h)) * HTB)
#define PG8_STAGE(bufoff, gbase, voff) do { _Pragma("unroll") for (int _i = 0; _i < 2; ++_i) \
        __builtin_amdgcn_global_load_lds((const unsigned*)((const char*)(gbase) + (voff)[_i]), (LAS unsigned*)(lds + (bufoff) + ldsw + _i * 8192), 16, 0, 0); } while (0)
#define PG8_LDA(dst, b, h) do { _Pragma("unroll") for (int m = 0; m < 4; ++m) _Pragma("unroll") for (int k = 0; k < 2; ++k) dst[m][k] = *(const LAS bf16x8*)(lds + PG8_SA(b, h) + aoff + m * 2048 + k * 1024); } while (0)
#define PG8_LDB(dst, b, h) do { _Pragma("unroll") for (int n = 0; n < 2; ++n) _Pragma("unroll") for (int k = 0; k < 2; ++k) dst[n][k] = *(const LAS bf16x8*)(lds + PG8_SB(b, h) + boff + n * 2048 + k * 1024); } while (0)
#define PG8_MMA(ai, bj, At, Bt) do { __builtin_amdgcn_s_setprio(1); _Pragma("unroll") for (int m = 0; m < 4; ++m) _Pragma("unroll") for (int n = 0; n < 2; ++n) _Pragma("unroll") for (int k = 0; k < 2; ++k) \
        acc[ai][bj][m][n] = __builtin_amdgcn_mfma_f32_16x16x32_bf16(Bt[n][k], At[m][k], acc[ai][bj][m][n], 0, 0, 0); __builtin_amdgcn_s_setprio(0); } while (0)
#define PG8_WAIT_V(n) asm volatile("s_waitcnt vmcnt(" #n ")" ::: "memory")
#define PG8_WAIT_L(n) asm volatile("s_waitcnt lgkmcnt(" #n ")" ::: "memory")
#define PG8_BAR __builtin_amdgcn_s_barrier()
#define PG8_SCHED __builtin_amdgcn_sched_barrier(0)
    Unit cur, nxt; int ui = 0;
    if (!S.next(0, cur)) return;
    f32x4 acc[2][2][4][2];
#pragma unroll
    for (int a = 0; a < 2; ++a)
#pragma unroll
        for (int b = 0; b < 2; ++b)
#pragma unroll
            for (int m = 0; m < 4; ++m)
#pragma unroll
                for (int n = 0; n < 2; ++n) acc[a][b][m][n] = (f32x4){0.f, 0.f, 0.f, 0.f};
    bf16x8 At[4][2], B0[2][2], B1[2][2];
    const char* cA = (const char*)g.A + (size_t)cur.pm * tstep; const char* cB = (const char*)g.Bt + (size_t)cur.pn * tstep;
    PG8_STAGE(PG8_SB(0, 0), cB, voffB); PG8_STAGE(PG8_SA(0, 0), cA, voffA); PG8_STAGE(PG8_SB(0, 1), cB + hstep, voffB); PG8_STAGE(PG8_SA(0, 1), cA + hstep, voffA);
    if (wr == 1) PG8_BAR;
    PG8_WAIT_V(4); PG8_BAR;
    PG8_STAGE(PG8_SB(1, 0), cB + kstep, voffB); PG8_STAGE(PG8_SA(1, 0), cA + kstep, voffA); PG8_STAGE(PG8_SB(1, 1), cB + hstep + kstep, voffB);
    PG8_WAIT_V(6); PG8_BAR;
    for (;;) {
        const bool has_next = S.next(ui + 1, nxt);
        const char* nA = has_next ? (const char*)g.A + (size_t)nxt.pm * tstep : cA; const char* nB = has_next ? (const char*)g.Bt + (size_t)nxt.pn * tstep : cB;
        for (int t = 0; t < nt; t += 2) {
            const bool last = (t == nt - 2);
            const char* a1 = cA + (size_t)(t + 1) * kstep;
            const char* a2 = last ? nA : cA + (size_t)(t + 2) * kstep; const char* b2 = last ? nB : cB + (size_t)(t + 2) * kstep;
            const char* a3 = a2 + kstep; const char* b3 = b2 + kstep;
            PG8_LDB(B0, 0, 0); PG8_SCHED; PG8_LDA(At, 0, 0); PG8_STAGE(PG8_SA(1, 1), a1 + hstep, voffA);
            PG8_WAIT_L(8); PG8_BAR; PG8_WAIT_L(0); PG8_MMA(0, 0, At, B0); PG8_BAR; PG8_SCHED;
            PG8_LDB(B1, 0, 1); PG8_STAGE(PG8_SB(0, 0), b2, voffB);
            PG8_BAR; PG8_WAIT_L(0); PG8_MMA(0, 1, At, B1); PG8_BAR;
            PG8_LDA(At, 0, 1); PG8_STAGE(PG8_SA(0, 0), a2, voffA);
            PG8_BAR; PG8_WAIT_L(0); PG8_MMA(1, 0, At, B0); PG8_BAR; PG8_SCHED;
            PG8_STAGE(PG8_SB(0, 1), b2 + hstep, voffB);
            PG8_WAIT_V(6); PG8_BAR; PG8_MMA(1, 1, At, B1); PG8_BAR;
            PG8_LDB(B0, 1, 0); PG8_SCHED; PG8_LDA(At, 1, 0); PG8_STAGE(PG8_SA(0, 1), a2 + hstep, voffA);
            PG8_WAIT_L(8); PG8_BAR; PG8_WAIT_L(0); PG8_MMA(0, 0, At, B0); PG8_BAR; PG8_SCHED;
            PG8_LDB(B1, 1, 1); PG8_STAGE(PG8_SB(1, 0), b3, voffB);
            PG8_BAR; PG8_WAIT_L(0); PG8_MMA(0, 1, At, B1); PG8_BAR;
            PG8_LDA(At, 1, 1); PG8_STAGE(PG8_SA(1, 0), a3, voffA);
            PG8_BAR; PG8_WAIT_L(0); PG8_MMA(1, 0, At, B0); PG8_BAR; PG8_SCHED;
            PG8_STAGE(PG8_SB(1, 1), b3 + hstep, voffB);
            PG8_WAIT_V(6); PG8_BAR; PG8_MMA(1, 1, At, B1); PG8_BAR;
        }
        E(acc, cur, wr, wc, fr, fq);
        if (!has_next) break;
#pragma unroll
        for (int a = 0; a < 2; ++a)
#pragma unroll
            for (int b = 0; b < 2; ++b)
#pragma unroll
                for (int m = 0; m < 4; ++m)
#pragma unroll
                    for (int n = 0; n < 2; ++n) acc[a][b][m][n] = (f32x4){0.f, 0.f, 0.f, 0.f};
        cur = nxt; cA = nA; cB = nB; ++ui;
    }
    PG8_WAIT_V(0);
    if (wr == 0) PG8_BAR;
    PG8_BAR;
#undef PG8_SA
#undef PG8_SB
#undef PG8_STAGE
#undef PG8_LDA
#undef PG8_LDB
#undef PG8_MMA
#undef PG8_WAIT_V
#undef PG8_WAIT_L
#undef PG8_BAR
#undef PG8_SCHED
}
}

struct WJob { const float* W; bf16_t* dst; int N, K, k0, n0, rowmode; };
constexpr int WT0 = 32 * 27, WT1 = WT0 + 32 * 8, WT2 = WT1 + 32 * 22, WT3 = WT2 + 32 * 22, WT4 = WT3 + 88 * 8;
__device__ __forceinline__ WJob wjob(const Params& p, int t) {
    WJob j;
    if (t < WT0) { j.W = p.w_in; j.dst = (bf16_t*)(p.ws + WS_WIN); j.N = PROJD; j.K = DM; j.k0 = (t / 27) * 64; j.n0 = (t % 27) * 256; j.rowmode = 0; }
    else if (t < WT1) { const int u = t - WT0; j.W = p.w_out; j.dst = (bf16_t*)(p.ws + WS_WOUT); j.N = DM; j.K = DM; j.k0 = (u / 8) * 64; j.n0 = (u % 8) * 256; j.rowmode = 0; }
    else if (t < WT2) { const int u = t - WT1; j.W = p.w_gate; j.dst = (bf16_t*)(p.ws + WS_WGU); j.N = DFF; j.K = DM; j.k0 = (u / 22) * 64; j.n0 = (u % 22) * 256; j.rowmode = 1; }
    else if (t < WT3) { const int u = t - WT2; j.W = p.w_up; j.dst = (bf16_t*)(p.ws + WS_WGU); j.N = DFF; j.K = DM; j.k0 = (u / 22) * 64; j.n0 = (u % 22) * 256; j.rowmode = 2; }
    else { const int u = t - WT3; j.W = p.w_down; j.dst = (bf16_t*)(p.ws + WS_WDN); j.N = DM; j.K = DFF; j.k0 = (u / 8) * 64; j.n0 = (u % 8) * 256; j.rowmode = 0; }
    return j;
}
__device__ __forceinline__ void wload(const WJob& j, f32x4 (&v)[8]) {
    const int tid = threadIdx.x, kk = tid >> 6, n = j.n0 + 4 * (tid & 63);
#pragma unroll
    for (int it = 0; it < 8; ++it) { v[it] = (f32x4){0.f, 0.f, 0.f, 0.f};
        if (n < j.N) v[it] = __builtin_nontemporal_load((const f32x4*)(j.W + (size_t)(j.k0 + kk + 8 * it) * j.N + n)); }
}
__device__ void weights_pass(const Params& p, LAS unsigned char* lds, int t_begin, int t_end, int worker, int nworkers) {
    LAS unsigned* tw = (LAS unsigned*)lds;
    const LAS bf16_t* th = (const LAS bf16_t*)lds;
    const int tid = threadIdx.x, kk = tid >> 6, n4 = tid & 63;
    int t = t_begin + worker;
    if (t >= t_end) return;
    f32x4 v[8];
    WJob cur = wjob(p, t);
    wload(cur, v);
    for (;;) {
#pragma unroll
        for (int it = 0; it < 8; ++it) { const int k = kk + 8 * it;
            tw[k * 129 + 2 * n4] = cvt_pk_bf16(v[it][0], v[it][1]); tw[k * 129 + 2 * n4 + 1] = cvt_pk_bf16(v[it][2], v[it][3]); }
        __syncthreads();
        const int tn = t + nworkers; const bool more = tn < t_end;
        WJob nxt = cur;
        if (more) { nxt = wjob(p, tn); wload(nxt, v); }
#pragma unroll
        for (int jj = 0; jj < 4; ++jj) {
            const int c = tid + 512 * jj, k8 = c & 7, nl = c >> 3, n = cur.n0 + nl;
            unsigned short e[8];
#pragma unroll
            for (int q = 0; q < 8; ++q) e[q] = th[(8 * k8 + q) * 258 + nl];
            if (n < cur.N) {
                int nr = n;
                if (cur.rowmode == 1) nr = 256 * (n >> 7) + (n & 127);
                else if (cur.rowmode == 2) nr = 256 * (n >> 7) + 128 + (n & 127);
                u32x4 w; w.x = (unsigned)e[0] | ((unsigned)e[1] << 16); w.y = (unsigned)e[2] | ((unsigned)e[3] << 16); w.z = (unsigned)e[4] | ((unsigned)e[5] << 16); w.w = (unsigned)e[6] | ((unsigned)e[7] << 16);
                *(u32x4*)(cur.dst + (size_t)nr * cur.K + cur.k0 + 8 * k8) = w;
            }
        }
        if (!more) break;
        __syncthreads();
        cur = nxt; t = tn;
    }
    __syncthreads();
}

__device__ void phase_prep(const Params& p, LAS unsigned char* lds) {
    const int tid = threadIdx.x, wid = tid >> 6, lane = tid & 63;
    bf16_t* win = (bf16_t*)(p.ws + WS_WIN);
    weights_pass(p, lds, 0, WT0, blockIdx.x, gridDim.x);
    const size_t gt = (size_t)blockIdx.x * 512 + tid, ngt = (size_t)gridDim.x * 512;
    {
        u32x4 z = {0u, 0u, 0u, 0u};
        u32x4* a = (u32x4*)(win + (size_t)PROJD * DM); const size_t na = (size_t)(PROJP - PROJD) * DM * 2 / 16;
        for (size_t i = gt; i < na; i += ngt) a[i] = z;
        u32x4* b = (u32x4*)((bf16_t*)(p.ws + WS_ABUF) + (size_t)MTOT * DM); const size_t nb = (size_t)(MPAD - MTOT) * DM * 2 / 16;
        for (size_t i = gt; i < nb; i += ngt) b[i] = z;
    }
    {
        float* tab = (float*)(p.ws + WS_TAB);
        for (size_t i = gt; i < (size_t)TABROWS * 128; i += ngt) {
            const int pi = (int)(i >> 7), f = (int)(i & 127);
            const float pos = pi < LP ? (float)pi : 16384.0f;
            const float inv = exp2f(-(float)f * (13.287712379549449f / 128.0f));
            const float ang = pos * inv;
            const double a = (double)ang;
            const double n = rint(a * 0.15915494309189535);
            double r = fma(-n, 6.283185307179586, a); r = fma(-n, 2.4492935982947064e-16, r);
            const float rf = (float)r;
            tab[(size_t)pi * 256 + f] = cosf(rf); tab[(size_t)pi * 256 + 128 + f] = sinf(rf);
        }
    }
    {
        bf16_t* U = (bf16_t*)(p.ws + WS_ABUF);
        for (int row = blockIdx.x * 8 + wid; row < MTOT; row += gridDim.x * 8) {
            const float* x = src_row(p, row);
            float4 v[8]; float ss = 0.f;
#pragma unroll
            for (int q = 0; q < 8; ++q) { v[q] = *(const float4*)(x + q * 256 + lane * 4); ss += v[q].x * v[q].x + v[q].y * v[q].y + v[q].z * v[q].z + v[q].w * v[q].w; }
            ss = wave_sum(ss);
            const float rs = rsqrtf(ss * (1.0f / DM) + EPS);
#pragma unroll
            for (int q = 0; q < 8; ++q) { const int col = q * 256 + lane * 4; const float4 g = *(const float4*)(p.pre_mix_g + col);
                u32x2 w; w.x = pack2(v[q].x * rs * g.x, v[q].y * rs * g.y); w.y = pack2(v[q].z * rs * g.z, v[q].w * rs * g.w);
                *(u32x2*)(U + (size_t)row * DM + col) = w; }
        }
    }
}

__device__ void phase_convrope(const Params& p) {
    const bf16_t* __restrict__ proj = (const bf16_t*)(p.ws + WS_PROJ);
    bf16_t* projw = (bf16_t*)(p.ws + WS_PROJ);
    bf16_t* __restrict__ XC = (bf16_t*)(p.ws + WS_XC);
    const float* __restrict__ tab = (const float*)(p.ws + WS_TAB);
    const unsigned gt = blockIdx.x * 512 + threadIdx.x, ngt = gridDim.x * 512;
#pragma unroll 2
    for (unsigned i = gt; i < (unsigned)(NBATCH * 516 * 192); i += ngt) {
        const int oct = i % 192, tg = (i / 192) % 516, b = i / (192 * 516), t0 = tg * 4, ch = oct * 8;
        if (t0 < NMETA && b > 0) continue;
        u32x4 rin[7];
#pragma unroll
        for (int rr = 0; rr < 7; ++rr) { const int t = t0 - 3 + rr;
            rin[rr] = (u32x4){0u, 0u, 0u, 0u};
            if (t >= 0) rin[rr] = *(const u32x4*)(proj + (unsigned)(prow(b, t) * PROJP + OX + ch)); }
        u32x4 o[4];
#pragma unroll
        for (int e2 = 0; e2 < 4; ++e2) {
            const float2 w0 = *(const float2*)(p.conv_w + 0 * CONVD + ch + 2 * e2), w1 = *(const float2*)(p.conv_w + 1 * CONVD + ch + 2 * e2);
            const float2 w2 = *(const float2*)(p.conv_w + 2 * CONVD + ch + 2 * e2), w3 = *(const float2*)(p.conv_w + 3 * CONVD + ch + 2 * e2);
            const float2 bb = *(const float2*)(p.conv_b + ch + 2 * e2);
#pragma unroll
            for (int r = 0; r < 4; ++r) {
                const float v0 = bb.x + w0.x * lo16(rin[r][e2]) + w1.x * lo16(rin[r + 1][e2]) + w2.x * lo16(rin[r + 2][e2]) + w3.x * lo16(rin[r + 3][e2]);
                const float v1 = bb.y + w0.y * hi16(rin[r][e2]) + w1.y * hi16(rin[r + 1][e2]) + w2.y * hi16(rin[r + 2][e2]) + w3.y * hi16(rin[r + 3][e2]);
                o[r][e2] = cvt_pk_bf16(silu_f(v0), silu_f(v1));
            }
        }
#pragma unroll
        for (int r = 0; r < 4; ++r) *(u32x4*)(XC + (unsigned)(prow(b, t0 + r) * CONVD + ch)) = o[r];
    }
    for (unsigned i = gt; i < (unsigned)(DECB * 192); i += ngt) {
        const int s = i / 192, ch = (i % 192) * 8;
        const float* sc = p.state_conv + (size_t)s * 3 * CONVD + ch;
        const u32x4 cur = *(const u32x4*)(proj + (unsigned)((SROW0 + s) * PROJP + OX + ch));
        float* oc = p.out + O_SCONV + (size_t)s * 3 * CONVD + ch;
        u32x4 o;
#pragma unroll
        for (int e4 = 0; e4 < 2; ++e4) {
            const float4 i0 = *(const float4*)(sc + 4 * e4), i1 = *(const float4*)(sc + CONVD + 4 * e4), i2 = *(const float4*)(sc + 2 * CONVD + 4 * e4);
            const float4 i3 = make_float4(lo16(cur[2 * e4]), hi16(cur[2 * e4]), lo16(cur[2 * e4 + 1]), hi16(cur[2 * e4 + 1]));
            const float4 w0 = *(const float4*)(p.conv_w + ch + 4 * e4), w1 = *(const float4*)(p.conv_w + CONVD + ch + 4 * e4);
            const float4 w2 = *(const float4*)(p.conv_w + 2 * CONVD + ch + 4 * e4), w3 = *(const float4*)(p.conv_w + 3 * CONVD + ch + 4 * e4);
            const float4 bb = *(const float4*)(p.conv_b + ch + 4 * e4);
            const float v0 = bb.x + w0.x * i0.x + w1.x * i1.x + w2.x * i2.x + w3.x * i3.x, v1 = bb.y + w0.y * i0.y + w1.y * i1.y + w2.y * i2.y + w3.y * i3.y;
            const float v2 = bb.z + w0.z * i0.z + w1.z * i1.z + w2.z * i2.z + w3.z * i3.z, v3 = bb.w + w0.w * i0.w + w1.w * i1.w + w2.w * i2.w + w3.w * i3.w;
            o[2 * e4] = cvt_pk_bf16(silu_f(v0), silu_f(v1)); o[2 * e4 + 1] = cvt_pk_bf16(silu_f(v2), silu_f(v3));
            *(float4*)(oc + 4 * e4) = i1; *(float4*)(oc + CONVD + 4 * e4) = i2; *(float4*)(oc + 2 * CONVD + 4 * e4) = i3;
        }
        *(u32x4*)(XC + (unsigned)((SROW0 + s) * CONVD + ch)) = o;
    }
    for (unsigned i = gt; i < (unsigned)(MTOT * 64); i += ngt) {
        const int row = i >> 6, hd = (i >> 4) & 3, d8 = i & 15;
        const int trow = row < MMAIN ? (row & (SEQL - 1)) + NMETA : (row < MROW0 ? LP : row - MROW0);
        bf16_t* base = projw + (unsigned)(row * PROJP + hd * 256 + 8 * d8);
        const u32x4 q1 = *(const u32x4*)(base + OQ), q2 = *(const u32x4*)(base + OQ + 128), k1 = *(const u32x4*)(base + OKK), k2 = *(const u32x4*)(base + OKK + 128);
        const float* tp = tab + (unsigned)(trow * 256 + 8 * d8);
        const f32x4 c0 = *(const f32x4*)(tp), c1 = *(const f32x4*)(tp + 4), s0 = *(const f32x4*)(tp + 128), s1 = *(const f32x4*)(tp + 132);
        const float cc[8] = {c0[0], c0[1], c0[2], c0[3], c1[0], c1[1], c1[2], c1[3]}, sn[8] = {s0[0], s0[1], s0[2], s0[3], s1[0], s1[1], s1[2], s1[3]};
        u32x4 qlo, qhi, klo, khi;
#pragma unroll
        for (int e = 0; e < 4; ++e) {
            const float a0 = lo16(q1[e]), a1 = hi16(q1[e]), b0 = lo16(q2[e]), b1 = hi16(q2[e]);
            qlo[e] = cvt_pk_bf16(a0 * cc[2 * e] - b0 * sn[2 * e], a1 * cc[2 * e + 1] - b1 * sn[2 * e + 1]);
            qhi[e] = cvt_pk_bf16(a0 * sn[2 * e] + b0 * cc[2 * e], a1 * sn[2 * e + 1] + b1 * cc[2 * e + 1]);
            const float x0 = lo16(k1[e]), x1 = hi16(k1[e]), y0 = lo16(k2[e]), y1 = hi16(k2[e]);
            klo[e] = cvt_pk_bf16((x0 * cc[2 * e] - y0 * sn[2 * e]) * 0.0625f, (x1 * cc[2 * e + 1] - y1 * sn[2 * e + 1]) * 0.0625f);
            khi[e] = cvt_pk_bf16((x0 * sn[2 * e] + y0 * cc[2 * e]) * 0.0625f, (x1 * sn[2 * e + 1] + y1 * cc[2 * e + 1]) * 0.0625f);
        }
        *(u32x4*)(base + OQ) = qlo; *(u32x4*)(base + OQ + 128) = qhi; *(u32x4*)(base + OKK) = klo; *(u32x4*)(base + OKK + 128) = khi;
    }
    for (unsigned i = gt; i < (unsigned)(NBATCH * 3 * CONVD); i += ngt) {
        const int b = i / (3 * CONVD), r = (i / CONVD) % 3, c = i % CONVD;
        p.out[O_PCONV + i] = bf2f(proj[(unsigned)((b * SEQL + SEQL - 3 + r) * PROJP + OX + c)]);
    }
}

__device__ __forceinline__ int step_row(int b, int step, int i) { return step == 0 ? MROW0 + i : b * SEQL + 64 * (step - 1) + i; }

constexpr int SMP_OFF = 104448;
constexpr int SMP_XC = 0, SMP_ZV = 768, SMP_HP = 1280, SMP_Q = 1312, SMP_K = 1824, SMP_V = 2336, SMP_RED = 2848, SMP_FLOATS = 2848 + 2048;
constexpr int NSLICE = 24;
static_assert(SMP_OFF + SMP_FLOATS * 4 <= LDS_ST, "sample block does not fit");

__device__ __forceinline__ void sample_setup(const Params& p, LAS float* sm, int s, int hf) {
    const int tid = threadIdx.x;
    const bf16_t* prw = (const bf16_t*)(p.ws + WS_PROJ) + (size_t)(SROW0 + s) * PROJP;
    const bf16_t* xcr = (const bf16_t*)(p.ws + WS_XC) + (size_t)(SROW0 + s) * CONVD;
    for (int li = tid; li < 768; li += 512) {
        const int c = li < 512 ? hf * 512 + li : (li < 640 ? 1024 + hf * 128 + (li - 512) : 1280 + hf * 128 + (li - 640));
        sm[SMP_XC + li] = bf2f(xcr[c]);
    }
    sm[SMP_ZV + tid] = bf2f(prw[OZ + hf * 512 + tid]);
    if (tid < 8) { const int h = hf * 8 + tid;
        const float dt = softplus_f(bf2f(prw[ODT + h]) + p.dt_bias[h]);
        sm[SMP_HP + tid * 4 + 0] = dt; sm[SMP_HP + tid * 4 + 1] = __expf(-dt * __expf(p.a_log[h])); sm[SMP_HP + tid * 4 + 2] = p.d_skip[h]; }
    { const int r2 = tid >> 8, d = tid & 255, hd = hf * 2 + r2;
      sm[SMP_Q + tid] = bf2f(prw[OQ + hd * 256 + d]); sm[SMP_K + tid] = bf2f(prw[OKK + hd * 256 + d]); sm[SMP_V + tid] = bf2f(prw[OV + hd * 256 + d]); }
}
__device__ __forceinline__ void sample_issue(const Params& p, int s, int hf, int slice, f32x4 (&r)[4]) {
    const int tid = threadIdx.x;
    if (slice < 8) {
        const float* hin = p.state_ssm + ((size_t)s * 16 + hf * 8 + slice) * 64 * 128 + (size_t)(tid >> 5) * 128 + 4 * (tid & 31);
#pragma unroll
        for (int i = 0; i < 4; ++i) r[i] = __builtin_nontemporal_load((const f32x4*)(hin + (size_t)i * 16 * 128));
    } else {
        const int r2 = (slice - 8) >> 3, part = (slice - 8) & 7;
        const float* sin_ = p.state_ret + ((size_t)s * 4 + hf * 2 + r2) * 256 * 256 + (size_t)((tid >> 6) + 32 * part) * 256 + 4 * (tid & 63);
#pragma unroll
        for (int i = 0; i < 4; ++i) r[i] = __builtin_nontemporal_load((const f32x4*)(sin_ + (size_t)i * 8 * 256));
    }
}
__device__ __forceinline__ void sample_process(const Params& p, LAS float* sm, int s, int hf, int slice, const f32x4 (&r)[4], f32x4& ya) {
    const int tid = threadIdx.x;
    if (slice < 8) {
        const int n4 = tid & 31, pbase = tid >> 5, h = hf * 8 + slice;
        const f32x4 Bq = *(const LAS f32x4*)(sm + SMP_XC + 512 + 4 * n4), Cq = *(const LAS f32x4*)(sm + SMP_XC + 640 + 4 * n4);
        const float dt = sm[SMP_HP + slice * 4], dec = sm[SMP_HP + slice * 4 + 1], dsk = sm[SMP_HP + slice * 4 + 2];
        float* hout = p.out + O_SSSM + ((size_t)s * 16 + h) * 64 * 128 + (size_t)pbase * 128 + 4 * n4;
        bf16_t* Y = (bf16_t*)(p.ws + WS_TMP) + (size_t)(SROW0 + s) * DM;
        float yp[4], xs[4];
#pragma unroll
        for (int i = 0; i < 4; ++i) {
            const int pp = pbase + 16 * i;
            xs[i] = sm[SMP_XC + slice * 64 + pp];
            const float dx = dt * xs[i];
            const f32x4 hn = dec * r[i] + dx * Bq;
            *(f32x4*)(hout + (size_t)i * 16 * 128) = hn;
            yp[i] = Cq[0] * hn[0] + Cq[1] * hn[1] + Cq[2] * hn[2] + Cq[3] * hn[3];
        }
        const bool b4 = (n4 & 16) != 0, b3 = (n4 & 8) != 0;
        const float t0 = __shfl_xor(b4 ? yp[0] : yp[2], 16), t1 = __shfl_xor(b4 ? yp[1] : yp[3], 16);
        const float a0 = (b4 ? yp[2] : yp[0]) + t0, a1 = (b4 ? yp[3] : yp[1]) + t1;
        float bsum = (b3 ? a1 : a0) + __shfl_xor(b3 ? a0 : a1, 8);
        bsum += __shfl_xor(bsum, 4); bsum += __shfl_xor(bsum, 2); bsum += __shfl_xor(bsum, 1);
        if ((n4 & 7) == 0) {
            const int i = (b4 ? 2 : 0) + (b3 ? 1 : 0), pp = pbase + 16 * i;
            const float xv = b4 ? (b3 ? xs[3] : xs[2]) : (b3 ? xs[1] : xs[0]);
            Y[h * 64 + pp] = f2bf((bsum + dsk * xv) * silu_f(sm[SMP_ZV + slice * 64 + pp]));
        }
    } else {
        const int r2 = (slice - 8) >> 3, part = (slice - 8) & 7, hd = hf * 2 + r2, v4 = tid & 63, d0 = (tid >> 6) + 32 * part;
        const float gam = __expf(hd == 0 ? p.lg0 : hd == 1 ? p.lg1 : hd == 2 ? p.lg2 : p.lg3);
        const f32x4 vq = *(const LAS f32x4*)(sm + SMP_V + r2 * 256 + 4 * v4);
        float* sout = p.out + O_SRET + ((size_t)s * 4 + hd) * 256 * 256 + (size_t)d0 * 256 + 4 * v4;
        if (part == 0) ya = (f32x4){0.f, 0.f, 0.f, 0.f};
#pragma unroll
        for (int i = 0; i < 4; ++i) {
            const int d = d0 + 8 * i;
            const float kd = sm[SMP_K + r2 * 256 + d], qd = sm[SMP_Q + r2 * 256 + d];
            const f32x4 sn = gam * r[i] + kd * vq;
            __builtin_nontemporal_store(sn, (f32x4*)(sout + (size_t)i * 8 * 256));
            ya += qd * sn;
        }
        if (part == 7) *(LAS f32x4*)(sm + SMP_RED + (tid >> 6) * 256 + 4 * v4) = ya;
    }
}
__device__ __forceinline__ void sample_finalize(const Params& p, LAS float* sm, int s, int hf, int r2) {
    const int tid = threadIdx.x;
    if (tid < 256) { float a = 0.f;
#pragma unroll
        for (int w = 0; w < 8; ++w) a += sm[SMP_RED + w * 256 + tid];
        ((bf16_t*)(p.ws + WS_TMP))[(size_t)(SROW0 + s) * DM + 1024 + (hf * 2 + r2) * 256 + tid] = f2bf(a); }
}

__device__ void ret_task(const Params& p, LAS unsigned char* lds, int b, int hd, int sl, int smp, int shf) {
    const int tid = threadIdx.x, wid = tid >> 6, lane = tid & 63, fr = lane & 15, fq = lane >> 4;
    LAS bf16_t* Qs = (LAS bf16_t*)lds;
    LAS bf16_t* Ks = Qs + 64 * 264;
    LAS bf16_t* Ps = Ks + 64 * 264;
    LAS bf16_t* Vs = Ps + 64 * 72;
    LAS bf16_t* Vw = Vs + 64 * 40;
    LAS bf16_t* St = Vw + 64 * 40;
    const bf16_t* proj = (const bf16_t*)(p.ws + WS_PROJ);
    bf16_t* Y = (bf16_t*)(p.ws + WS_TMP);
    const float lg = hd == 0 ? p.lg0 : hd == 1 ? p.lg1 : hd == 2 ? p.lg2 : p.lg3;
    for (int i = tid; i < 32 * 264 / 2; i += 512) ((LAS unsigned*)St)[i] = 0u;
    f32x4 sacc[4];
#pragma unroll
    for (int i = 0; i < 4; ++i) sacc[i] = (f32x4){0.f, 0.f, 0.f, 0.f};
    u32x4 rq[4], rk[4], rv;
    const int crow = tid >> 5, cch = tid & 31, vrow = tid >> 2, v8 = tid & 3;
    auto issue = [&](int step) {
        const int nv = step == 0 ? NMETA : 64;
#pragma unroll
        for (int i = 0; i < 4; ++i) { const int row = crow + 16 * i;
            rq[i] = (u32x4){0u, 0u, 0u, 0u}; rk[i] = rq[i];
            if (row < nv) { const bf16_t* base = proj + (unsigned)(step_row(b, step, row) * PROJP + hd * 256 + 8 * cch);
                rq[i] = *(const u32x4*)(base + OQ); rk[i] = *(const u32x4*)(base + OKK); } }
        rv = (u32x4){0u, 0u, 0u, 0u};
        if (tid < 256 && vrow < nv) rv = *(const u32x4*)(proj + (unsigned)(step_row(b, step, vrow) * PROJP + OV + hd * 256 + sl * 32 + 8 * v8));
    };
    LAS float* sm = (LAS float*)(lds + SMP_OFF);
    sample_setup(p, sm, smp, shf);
    f32x4 sr[4]; f32x4 sya = {0.f, 0.f, 0.f, 0.f};
    issue(0);
    __syncthreads();
    for (int step = 0; step < NSTEP; ++step) {
        const int nv = step == 0 ? NMETA : 64;
#pragma unroll
        for (int i = 0; i < 4; ++i) { const int row = crow + 16 * i;
            *(LAS u32x4*)(Qs + row * 264 + 8 * cch) = rq[i]; *(LAS u32x4*)(Ks + row * 264 + 8 * cch) = rk[i]; }
        if (tid < 256) {
            const float wk = __expf((float)(nv - 1 - vrow) * lg);
            u32x4 vw;
#pragma unroll
            for (int e = 0; e < 4; ++e) vw[e] = pack2(lo16(rv[e]) * wk, hi16(rv[e]) * wk);
            *(LAS u32x4*)(Vs + vrow * 40 + 8 * v8) = rv; *(LAS u32x4*)(Vw + vrow * 40 + 8 * v8) = vw;
        }
        __syncthreads();
        if (step == 16 || step == 24) sample_finalize(p, sm, smp, shf, step == 16 ? 0 : 1);
        if (step + 1 < NSTEP) issue(step + 1);
        if (step < NSLICE) sample_issue(p, smp, shf, step, sr);
        const int ib = wid >> 1, vb = wid & 1;
        f32x4 acc3 = {0.f, 0.f, 0.f, 0.f};
        {
            f32x4 sc[2]; sc[0] = (f32x4){0.f, 0.f, 0.f, 0.f}; sc[1] = sc[0];
            const int jb0 = 2 * vb;
            mma16x3<256>(sc[0], sc[1], acc3, Qs + ib * 16 * 264, Ks + jb0 * 16 * 264, Ks + (jb0 + 1) * 16 * 264, St + vb * 16 * 264, 264, fr, fq);
#pragma unroll
            for (int tt = 0; tt < 2; ++tt) {
                const int jb = jb0 + tt;
#pragma unroll
                for (int r = 0; r < 4; ++r) { const int i = ib * 16 + fq * 4 + r, j = jb * 16 + fr;
                    const float val = (j <= i) ? sc[tt][r] * __expf((float)(i - j) * lg) : 0.f;
                    Ps[i * 72 + j] = f2bf(val); }
            }
        }
        __syncthreads();
        f32x4 acc2 = {0.f, 0.f, 0.f, 0.f};
#pragma unroll
        for (int k0 = 0; k0 < 64; k0 += 32) acc2 = MFMA16(ld_row(Ps + ib * 16 * 72, 72, k0, fr, fq), ld_tr(Vs + vb * 16, 40, k0, fr, fq), acc2);
        if (step > 0) {
#pragma unroll
            for (int r = 0; r < 4; ++r) { const int i = ib * 16 + fq * 4 + r;
                Y[(unsigned)(step_row(b, step, i) * DM + 1024 + hd * 256 + sl * 32 + vb * 16 + fr)] = f2bf(acc2[r] + __expf((float)(i + 1) * lg) * acc3[r]); }
        }
        const float dec = __expf((float)nv * lg);
#pragma unroll
        for (int tt = 0; tt < 4; ++tt) {
            const int db = 2 * wid + (tt >> 1), vb2 = tt & 1;
            sacc[tt] *= dec;
#pragma unroll
            for (int k0 = 0; k0 < 64; k0 += 32) sacc[tt] = MFMA16(ld_tr(Ks + db * 16, 264, k0, fr, fq), ld_tr(Vw + vb2 * 16, 40, k0, fr, fq), sacc[tt]);
        }
        if (step < NSLICE) sample_process(p, sm, smp, shf, step, sr, sya);
        __syncthreads();
#pragma unroll
        for (int tt = 0; tt < 4; ++tt) {
            const int db = 2 * wid + (tt >> 1), vb2 = tt & 1;
            u32x2 w; w.x = pack2(sacc[tt][0], sacc[tt][1]); w.y = pack2(sacc[tt][2], sacc[tt][3]);
            *(LAS u32x2*)(St + (vb2 * 16 + fr) * 264 + db * 16 + fq * 4) = w;
        }
    }
    float* o = p.out + O_PRET + (size_t)(b * 4 + hd) * 256 * 256;
#pragma unroll
    for (int tt = 0; tt < 4; ++tt) { const int db = 2 * wid + (tt >> 1), vb2 = tt & 1;
#pragma unroll
        for (int r = 0; r < 4; ++r) o[(size_t)(db * 16 + fq * 4 + r) * 256 + sl * 32 + vb2 * 16 + fr] = sacc[tt][r]; }
}

__device__ void ssd_task(const Params& p, LAS unsigned char* lds, int b, int h, int ph, int smp, int shf) {
    const int tid = threadIdx.x, wid = tid >> 6, lane = tid & 63, fr = lane & 15, fq = lane >> 4, g = h >> 3;
    LAS bf16_t* Cs = (LAS bf16_t*)lds;
    LAS bf16_t* Bs = Cs + 64 * 136;
    LAS bf16_t* Bw = Bs + 64 * 136;
    LAS bf16_t* Ps = Bw + 64 * 136;
    LAS bf16_t* Xs = Ps + 64 * 72;
    LAS bf16_t* Hs = Xs + 64 * 40;
    LAS float* dtA = (LAS float*)(Hs + 32 * 136);
    LAS float* lcA = dtA + NSTEP * 64;
    const bf16_t* proj = (const bf16_t*)(p.ws + WS_PROJ);
    const bf16_t* XC = (const bf16_t*)(p.ws + WS_XC);
    bf16_t* Y = (bf16_t*)(p.ws + WS_TMP);
    const float a_neg = -__expf(p.a_log[h]), dtb = p.dt_bias[h], dsk = p.d_skip[h];
    for (int step = wid; step < NSTEP; step += 8) {
        const int nv = step == 0 ? NMETA : 64;
        float dt = 0.f;
        if (lane < nv) dt = softplus_f(bf2f(proj[(unsigned)(step_row(b, step, lane) * PROJP + ODT + h)]) + dtb);
        float x = dt * a_neg;
#pragma unroll
        for (int o = 1; o < 64; o <<= 1) { const float y = __shfl_up(x, o); if (lane >= o) x += y; }
        dtA[step * 64 + lane] = dt; lcA[step * 64 + lane] = x;
    }
    for (int i = tid; i < 32 * 136 / 2; i += 512) ((LAS unsigned*)Hs)[i] = 0u;
    f32x4 hacc[2];
    hacc[0] = (f32x4){0.f, 0.f, 0.f, 0.f}; hacc[1] = hacc[0];
    u32x4 rb[2], rc[2], rx; bf16_t rz[4] = {0, 0, 0, 0};
    const int brow = tid >> 4, bch = tid & 15, xrow = tid >> 2, x8 = tid & 3;
    auto issue = [&](int step) {
        const int nv = step == 0 ? NMETA : 64;
#pragma unroll
        for (int i = 0; i < 2; ++i) { const int row = brow + 32 * i;
            rb[i] = (u32x4){0u, 0u, 0u, 0u}; rc[i] = rb[i];
            if (row < nv) { const bf16_t* base = XC + (unsigned)(step_row(b, step, row) * CONVD + g * 128 + 8 * bch);
                rb[i] = *(const u32x4*)(base + 1024); rc[i] = *(const u32x4*)(base + 1280); } }
        rx = (u32x4){0u, 0u, 0u, 0u};
        if (tid < 256 && xrow < nv) rx = *(const u32x4*)(XC + (unsigned)(step_row(b, step, xrow) * CONVD + h * 64 + ph * 32 + 8 * x8));
        if (step > 0) {
#pragma unroll
            for (int r = 0; r < 4; ++r) rz[r] = proj[(unsigned)(step_row(b, step, (wid >> 1) * 16 + fq * 4 + r) * PROJP + OZ + h * 64 + ph * 32 + (wid & 1) * 16 + fr)];
        }
    };
    LAS float* sm = (LAS float*)(lds + SMP_OFF);
    sample_setup(p, sm, smp, shf);
    f32x4 sr[4]; f32x4 sya = {0.f, 0.f, 0.f, 0.f};
    issue(0);
    __syncthreads();
    for (int step = 0; step < NSTEP; ++step) {
        const LAS float* dtS = dtA + step * 64; const LAS float* lcS = lcA + step * 64;
        const float lc_last = lcS[63];
#pragma unroll
        for (int i = 0; i < 2; ++i) { const int row = brow + 32 * i;
            const float wts = __expf(lc_last - lcS[row]) * dtS[row];
            u32x4 w;
#pragma unroll
            for (int e = 0; e < 4; ++e) w[e] = pack2(lo16(rb[i][e]) * wts, hi16(rb[i][e]) * wts);
            *(LAS u32x4*)(Bs + row * 136 + 8 * bch) = rb[i]; *(LAS u32x4*)(Bw + row * 136 + 8 * bch) = w; *(LAS u32x4*)(Cs + row * 136 + 8 * bch) = rc[i]; }
        if (tid < 256) *(LAS u32x4*)(Xs + xrow * 40 + 8 * x8) = rx;
        __syncthreads();
        if (step == 16 || step == 24) sample_finalize(p, sm, smp, shf, step == 16 ? 0 : 1);
        float zc[4];
#pragma unroll
        for (int r = 0; r < 4; ++r) zc[r] = bf2f(rz[r]);
        if (step + 1 < NSTEP) issue(step + 1);
        if (step < NSLICE) sample_issue(p, smp, shf, step, sr);
        const int ib = wid >> 1, pb = wid & 1;
        f32x4 acc3 = {0.f, 0.f, 0.f, 0.f};
        {
            f32x4 sc[2]; sc[0] = (f32x4){0.f, 0.f, 0.f, 0.f}; sc[1] = sc[0];
            const int jb0 = 2 * pb;
            mma16x3<128>(sc[0], sc[1], acc3, Cs + ib * 16 * 136, Bs + jb0 * 16 * 136, Bs + (jb0 + 1) * 16 * 136, Hs + pb * 16 * 136, 136, fr, fq);
#pragma unroll
            for (int tt = 0; tt < 2; ++tt) {
                const int j = (jb0 + tt) * 16 + fr; const float lcj = lcS[j], dtj = dtS[j];
#pragma unroll
                for (int r = 0; r < 4; ++r) { const int i = ib * 16 + fq * 4 + r;
                    const float val = (j <= i) ? sc[tt][r] * __expf(lcS[i] - lcj) * dtj : 0.f;
                    Ps[i * 72 + j] = f2bf(val); }
            }
        }
        __syncthreads();
        f32x4 acc2 = {0.f, 0.f, 0.f, 0.f};
#pragma unroll
        for (int k0 = 0; k0 < 64; k0 += 32) acc2 = MFMA16(ld_row(Ps + ib * 16 * 72, 72, k0, fr, fq), ld_tr(Xs + pb * 16, 40, k0, fr, fq), acc2);
        if (step > 0) {
#pragma unroll
            for (int r = 0; r < 4; ++r) { const int i = ib * 16 + fq * 4 + r, pl = pb * 16 + fr;
                const float xv = bf2f(Xs[i * 40 + pl]);
                const float yv = acc2[r] + __expf(lcS[i]) * acc3[r] + dsk * xv;
                const unsigned grow = (unsigned)step_row(b, step, i);
                const float z = zc[r];
                Y[grow * DM + h * 64 + ph * 32 + pl] = f2bf(yv * silu_f(z)); }
        }
        const float dec = __expf(lc_last);
#pragma unroll
        for (int tt = 0; tt < 2; ++tt) {
            hacc[tt] *= dec;
#pragma unroll
            for (int k0 = 0; k0 < 64; k0 += 32) hacc[tt] = MFMA16(ld_tr(Xs + tt * 16, 40, k0, fr, fq), ld_tr(Bw + wid * 16, 136, k0, fr, fq), hacc[tt]);
        }
        if (step < NSLICE) sample_process(p, sm, smp, shf, step, sr, sya);
        __syncthreads();
#pragma unroll
        for (int tt = 0; tt < 2; ++tt)
#pragma unroll
            for (int r = 0; r < 4; ++r) Hs[(tt * 16 + fq * 4 + r) * 136 + wid * 16 + fr] = f2bf(hacc[tt][r]);
    }
    float* o = p.out + O_PSSM + (size_t)(b * 16 + h) * 64 * 128;
#pragma unroll
    for (int tt = 0; tt < 2; ++tt)
#pragma unroll
        for (int r = 0; r < 4; ++r) o[(size_t)(ph * 32 + tt * 16 + fq * 4 + r) * 128 + wid * 16 + fr] = hacc[tt][r];
}

__device__ void phase_mixers(const Params& p, LAS unsigned char* lds) {
    for (int t = blockIdx.x; t < 128; t += gridDim.x) {
        const int x = t & 7, k = t >> 3, task = (x * 2 + (k >> 3)) * 8 + (k & 7);
        ret_task(p, lds, task >> 5, (task >> 3) & 3, task & 7, t >> 1, t & 1);
        __syncthreads();
    }
    for (int t = blockIdx.x; t < 256; t += gridDim.x) {
        if (t >= 128) { const int tt = t - 128, u = (tt & 7) * 16 + (tt >> 3); ssd_task(p, lds, u >> 5, (u >> 1) & 15, u & 1, t >> 1, t & 1); __syncthreads(); }
    }
}

__device__ void aux_gemm(const bf16_t* __restrict__ A, int lda, const bf16_t* __restrict__ Bt, int K, float* __restrict__ C0, float* __restrict__ C1) {
    const int tid = threadIdx.x, wid = tid >> 6, lane = tid & 63, fr = lane & 15, fq = lane >> 4;
    for (int task = blockIdx.x; task < 256; task += gridDim.x) {
        const int cb = task & 127, kh = task >> 7, Kh = K >> 1;
        const bf16_t* ap = A + (size_t)(16 * wid + fr) * lda + kh * Kh + 8 * fq;
        const bf16_t* bp = Bt + (size_t)(cb * 16 + fr) * K + kh * Kh + 8 * fq;
        f32x4 acc0 = {0.f, 0.f, 0.f, 0.f}, acc1 = acc0;
#pragma unroll 4
        for (int k = 0; k < Kh; k += 64) {
            const bf16x8 a0 = *(const bf16x8*)(ap + k), b0 = *(const bf16x8*)(bp + k);
            const bf16x8 a1 = *(const bf16x8*)(ap + k + 32), b1 = *(const bf16x8*)(bp + k + 32);
            acc0 = MFMA16(a0, b0, acc0); acc1 = MFMA16(a1, b1, acc1);
        }
        float* C = kh ? C1 : C0;
#pragma unroll
        for (int r = 0; r < 4; ++r) C[(size_t)(16 * wid + fq * 4 + r) * DM + cb * 16 + fr] = acc0[r] + acc1[r];
    }
}

__device__ __forceinline__ void wave_sum8(float (&s)[8]) {
    const int lane = threadIdx.x & 63; const bool b5 = (lane & 32) != 0, b4 = (lane & 16) != 0, b3 = (lane & 8) != 0;
    float a[4], c[2];
#pragma unroll
    for (int k = 0; k < 4; ++k) a[k] = (b5 ? s[k + 4] : s[k]) + __shfl_xor(b5 ? s[k] : s[k + 4], 32);
#pragma unroll
    for (int k = 0; k < 2; ++k) c[k] = (b4 ? a[k + 2] : a[k]) + __shfl_xor(b4 ? a[k] : a[k + 2], 16);
    float d = (b3 ? c[1] : c[0]) + __shfl_xor(b3 ? c[0] : c[1], 8);
    d += __shfl_xor(d, 4); d += __shfl_xor(d, 2); d += __shfl_xor(d, 1);
#pragma unroll
    for (int q = 0; q < 8; ++q) s[q] = __int_as_float(__builtin_amdgcn_readlane(__float_as_int(d), q * 8));
}
__device__ void phase_normmix(const Params& p) {
    const int wid = threadIdx.x >> 6, lane = threadIdx.x & 63, nw = gridDim.x * 8;
    const bf16_t* Y = (const bf16_t*)(p.ws + WS_TMP);
    const bf16_t* proj = (const bf16_t*)(p.ws + WS_PROJ);
    bf16_t* MIX = (bf16_t*)(p.ws + WS_ABUF);
    for (int row0 = blockIdx.x * 8 + wid; row0 < MOUT; row0 += 2 * nw) {
        float4 v[2][8]; u32x2 gg[2][4];
#pragma unroll
        for (int u = 0; u < 2; ++u) { const int row = row0 + u * nw;
            if (row < MOUT) { const bf16_t* y = Y + (size_t)row * DM;
#pragma unroll
                for (int q = 0; q < 8; ++q) v[u][q] = ld4bf(y + q * 256 + lane * 4);
#pragma unroll
                for (int q = 0; q < 4; ++q) gg[u][q] = *(const u32x2*)(proj + (size_t)row * PROJP + OG + q * 256 + lane * 4); } }
#pragma unroll
        for (int u = 0; u < 2; ++u) { const int row = row0 + u * nw;
            if (row < MOUT) {
                float ss[8];
#pragma unroll
                for (int q = 0; q < 8; ++q) ss[q] = v[u][q].x * v[u][q].x + v[u][q].y * v[u][q].y + v[u][q].z * v[u][q].z + v[u][q].w * v[u][q].w;
                wave_sum8(ss);
                float rs[8];
                rs[0] = rs[1] = rsqrtf((ss[0] + ss[1]) * (1.0f / 512.0f) + EPS);
                rs[2] = rs[3] = rsqrtf((ss[2] + ss[3]) * (1.0f / 512.0f) + EPS);
#pragma unroll
                for (int q = 4; q < 8; ++q) rs[q] = rsqrtf(ss[q] * (1.0f / 256.0f) + EPS);
#pragma unroll
                for (int q = 0; q < 8; ++q) {
                    const int col = q * 256 + lane * 4;
                    float4 g; float4 o; const float4 w4 = v[u][q];
                    if (q < 4) { g = *(const float4*)(p.ssm_norm_g + col); o.x = w4.x * rs[q] * g.x; o.y = w4.y * rs[q] * g.y; o.z = w4.z * rs[q] * g.z; o.w = w4.w * rs[q] * g.w; }
                    else { g = *(const float4*)(p.ret_norm_g + col - 1024);
                        const u32x2 gq = gg[u][q - 4];
                        o.x = w4.x * rs[q] * g.x * silu_f(lo16(gq.x)); o.y = w4.y * rs[q] * g.y * silu_f(hi16(gq.x));
                        o.z = w4.z * rs[q] * g.z * silu_f(lo16(gq.y)); o.w = w4.w * rs[q] * g.w * silu_f(hi16(gq.y)); }
                    u32x2 w; w.x = pack2(o.x, o.y); w.y = pack2(o.z, o.w);
                    *(u32x2*)(MIX + (size_t)row * DM + col) = w;
                }
            } }
    }
}

__device__ void phase_mid(const Params& p) {
    const int wid = threadIdx.x >> 6, lane = threadIdx.x & 63, nw = gridDim.x * 8;
    const bf16_t* T = (const bf16_t*)(p.ws + WS_TMP);
    bf16_t* H1 = (bf16_t*)(p.ws + WS_H1);
    bf16_t* F = (bf16_t*)(p.ws + WS_ABUF);
    for (int row0 = blockIdx.x * 8 + wid; row0 < MOUT; row0 += 2 * nw) {
        float4 v[2][8], hx[2][8];
#pragma unroll
        for (int u = 0; u < 2; ++u) { const int row = row0 + u * nw;
            if (row < MOUT) { const bf16_t* t = T + (size_t)row * DM; const float* x = src_row(p, row);
                const float* t2 = (const float*)(p.ws + WS_AUX2) + (size_t)(row - SROW0) * DM;
#pragma unroll
                for (int q = 0; q < 8; ++q) { hx[u][q] = *(const float4*)(x + q * 256 + lane * 4);
                    if (row >= SROW0) { const float4 a = *(const float4*)(t2 + q * 256 + lane * 4), w = *(const float4*)(t2 + (size_t)DECB * DM + q * 256 + lane * 4);
                        v[u][q] = make_float4(a.x + w.x, a.y + w.y, a.z + w.z, a.w + w.w); }
                    else v[u][q] = ld4bf(t + q * 256 + lane * 4); } } }
#pragma unroll
        for (int u = 0; u < 2; ++u) { const int row = row0 + u * nw;
            if (row < MOUT) {
                float ss = 0.f;
#pragma unroll
                for (int q = 0; q < 8; ++q) ss += v[u][q].x * v[u][q].x + v[u][q].y * v[u][q].y + v[u][q].z * v[u][q].z + v[u][q].w * v[u][q].w;
                ss = wave_sum(ss);
                const float rs = rsqrtf(ss * (1.0f / DM) + EPS);
                float ss2 = 0.f;
#pragma unroll
                for (int q = 0; q < 8; ++q) { const int col = q * 256 + lane * 4; const float4 g = *(const float4*)(p.post_mix_g + col); const float4 h = hx[u][q];
                    float4& w = v[u][q];
                    w.x = h.x + w.x * rs * g.x; w.y = h.y + w.y * rs * g.y; w.z = h.z + w.z * rs * g.z; w.w = h.w + w.w * rs * g.w;
                    { u32x2 hw; hw.x = pack2(w.x, w.y); hw.y = pack2(w.z, w.w); *(u32x2*)(H1 + (size_t)row * DM + col) = hw; }
                    ss2 += w.x * w.x + w.y * w.y + w.z * w.z + w.w * w.w; }
                ss2 = wave_sum(ss2);
                const float rs2 = rsqrtf(ss2 * (1.0f / DM) + EPS);
#pragma unroll
                for (int q = 0; q < 8; ++q) { const int col = q * 256 + lane * 4; const float4 g = *(const float4*)(p.pre_ffn_g + col);
                    u32x2 w; w.x = pack2(v[u][q].x * rs2 * g.x, v[u][q].y * rs2 * g.y); w.y = pack2(v[u][q].z * rs2 * g.z, v[u][q].w * rs2 * g.w);
                    *(u32x2*)(F + (size_t)row * DM + col) = w; }
            } }
    }
}

__device__ void phase_final(const Params& p) {
    const int wid = threadIdx.x >> 6, lane = threadIdx.x & 63, nw = gridDim.x * 8;
    const bf16_t* T = (const bf16_t*)(p.ws + WS_TMP);
    const bf16_t* H1 = (const bf16_t*)(p.ws + WS_H1);
    for (int row0 = blockIdx.x * 8 + wid; row0 < MOUT; row0 += 2 * nw) {
        float4 v[2][8], hx[2][8];
#pragma unroll
        for (int u = 0; u < 2; ++u) { const int row = row0 + u * nw;
            if (row < MOUT) { const bf16_t* t = T + (size_t)row * DM; const bf16_t* h = H1 + (size_t)row * DM;
                const float* t2 = (const float*)(p.ws + WS_AUX2) + (size_t)(row - SROW0) * DM;
#pragma unroll
                for (int q = 0; q < 8; ++q) { hx[u][q] = ld4bf(h + q * 256 + lane * 4);
                    if (row >= SROW0) { const float4 a = *(const float4*)(t2 + q * 256 + lane * 4), w = *(const float4*)(t2 + (size_t)DECB * DM + q * 256 + lane * 4);
                        v[u][q] = make_float4(a.x + w.x, a.y + w.y, a.z + w.z, a.w + w.w); }
                    else v[u][q] = ld4bf(t + q * 256 + lane * 4); } } }
#pragma unroll
        for (int u = 0; u < 2; ++u) { const int row = row0 + u * nw;
            if (row < MOUT) {
                float* o = row < MMAIN ? p.out + O_YP + (size_t)row * DM : p.out + O_YS + (size_t)(row - SROW0) * DM;
                float ss = 0.f;
#pragma unroll
                for (int q = 0; q < 8; ++q) ss += v[u][q].x * v[u][q].x + v[u][q].y * v[u][q].y + v[u][q].z * v[u][q].z + v[u][q].w * v[u][q].w;
                ss = wave_sum(ss);
                const float rs = rsqrtf(ss * (1.0f / DM) + EPS);
#pragma unroll
                for (int q = 0; q < 8; ++q) { const int col = q * 256 + lane * 4; const float4 g = *(const float4*)(p.post_ffn_g + col); const float4 hh = hx[u][q];
                    float4 r; r.x = hh.x + v[u][q].x * rs * g.x; r.y = hh.y + v[u][q].y * rs * g.y; r.z = hh.z + v[u][q].z * rs * g.z; r.w = hh.w + v[u][q].w * rs * g.w;
                    *(float4*)(o + col) = r; }
            } }
    }
}

__global__ void __launch_bounds__(512, 2) hymba_mega(Params p) {
    extern __shared__ __attribute__((aligned(16))) unsigned char shm[];
    LAS unsigned char* lds = (LAS unsigned char*)shm;
    cg::grid_group grid = cg::this_grid();
    volatile LAS unsigned* xst = (volatile LAS unsigned*)(lds + LDS_ST);
    if (threadIdx.x < 4) xst[threadIdx.x] = 0u;
    __syncthreads();
    const XcdBarrier xb = xcd_barrier_post((unsigned*)(p.ws + WS_BAR), xst);
#define PHASE(i) if (p.ph_lo <= (i) && (i) < p.ph_hi)
#define SEAM(i) do { if (p.ph_lo <= (i) && (i) + 1 < p.ph_hi) { if (p.coop == 1) xcd_barrier(xb); else if (p.coop == 2) grid.sync(); } } while (0)
    PHASE(0) phase_prep(p, lds);
    SEAM(0);
    PHASE(1) {
        pg8::Gemm g{(const bf16_t*)(p.ws + WS_ABUF), (const bf16_t*)(p.ws + WS_WIN), MPAD, PROJP, DM};
        pg8::StaticOrder S; S.init(MPAD, PROJP, gridDim.x, blockIdx.x);
        pg8::EpiBf16 E{(bf16_t*)(p.ws + WS_PROJ), PROJP};
        pg8::gemm_phase(lds, g, S, E);
        {
            const int G = gridDim.x, r = S.nwg % G, c = blockIdx.x;
            __syncthreads();
            if (r == 0) weights_pass(p, lds, WT0, WT3, c, G);
            else if (c >= r) weights_pass(p, lds, WT0, WT3, c - r, G - r);
        }
    }
    SEAM(1);
    PHASE(2) phase_convrope(p);
    SEAM(2);
    PHASE(3) phase_mixers(p, lds);
    SEAM(3);
    PHASE(4) phase_normmix(p);
    SEAM(4);
    PHASE(5) {
        pg8::Gemm g{(const bf16_t*)(p.ws + WS_ABUF), (const bf16_t*)(p.ws + WS_WOUT), MMAIN, DM, DM};
        pg8::StaticOrder S; S.init(MMAIN, DM, gridDim.x, blockIdx.x);
        pg8::EpiBf16 E{(bf16_t*)(p.ws + WS_TMP), DM};
        pg8::gemm_phase(lds, g, S, E);
        aux_gemm((const bf16_t*)(p.ws + WS_ABUF) + (size_t)SROW0 * DM, DM, (const bf16_t*)(p.ws + WS_WOUT), DM, (float*)(p.ws + WS_AUX2), (float*)(p.ws + WS_AUX2) + (size_t)DECB * DM);
    }
    SEAM(5);
    PHASE(6) phase_mid(p);
    SEAM(6);
    PHASE(7) {
        pg8::Gemm g{(const bf16_t*)(p.ws + WS_ABUF), (const bf16_t*)(p.ws + WS_WGU), MPAD, 2 * DFF, DM};
        pg8::StaticOrder S; S.init(MPAD, 2 * DFF, gridDim.x, blockIdx.x);
        pg8::EpiSwiGLU E{(bf16_t*)(p.ws + WS_PROJ), DFF};
        pg8::gemm_phase(lds, g, S, E);
        {
            const int G = gridDim.x, r = S.nwg % G, c = blockIdx.x;
            __syncthreads();
            if (r == 0) weights_pass(p, lds, WT3, WT4, c, G);
            else if (c >= r) weights_pass(p, lds, WT3, WT4, c - r, G - r);
        }
    }
    SEAM(7);
    PHASE(8) {
        pg8::Gemm g{(const bf16_t*)(p.ws + WS_PROJ), (const bf16_t*)(p.ws + WS_WDN), MMAIN, DM, DFF};
        pg8::StaticOrder S; S.init(MMAIN, DM, gridDim.x, blockIdx.x);
        pg8::EpiBf16 E{(bf16_t*)(p.ws + WS_TMP), DM};
        pg8::gemm_phase(lds, g, S, E);
        aux_gemm((const bf16_t*)(p.ws + WS_PROJ) + (size_t)SROW0 * DFF, DFF, (const bf16_t*)(p.ws + WS_WDN), DFF, (float*)(p.ws + WS_AUX2), (float*)(p.ws + WS_AUX2) + (size_t)DECB * DM);
    }
    SEAM(8);
    PHASE(9) phase_final(p);
#undef PHASE
#undef SEAM
}

extern "C" void kernel_launch(void* const* d_in, const int* in_sizes, int n_in, void* d_out, int out_size, void* d_ws, size_t ws_size, hipStream_t stream) {
    static int grid = 0;
    if (grid == 0) {
        if (n_in != 22 || (size_t)out_size != O_END || ws_size < WS_END) { fprintf(stderr, "kernel_launch: unexpected shapes (n_in %d out %d ws %zu need %zu)\n", n_in, out_size, ws_size, (size_t)WS_END); grid = -1; return; }
        int dev = 0, cus = 0, per_cu = 0;
        (void)hipGetDevice(&dev);
        (void)hipDeviceGetAttribute(&cus, hipDeviceAttributeMultiprocessorCount, dev);
        if (hipFuncSetAttribute((const void*)hymba_mega, hipFuncAttributeMaxDynamicSharedMemorySize, LDS_BYTES) != hipSuccess) { fprintf(stderr, "kernel_launch: hipFuncSetAttribute failed\n"); grid = -1; return; }
        if (hipOccupancyMaxActiveBlocksPerMultiprocessor(&per_cu, (const void*)hymba_mega, 512, LDS_BYTES) != hipSuccess || per_cu < 1) { fprintf(stderr, "kernel_launch: occupancy query gave %d\n", per_cu); per_cu = 1; }
        (void)hipGetLastError();
        grid = cus * 1;
        if (grid <= 0) grid = 256;
    }
    if (grid < 0) return;
    Params p;
    memset(&p, 0, sizeof(p));
    const float** f = (const float**)&p;
    for (int i = 0; i < 22; ++i) f[i] = (const float*)d_in[i];
    p.out = (float*)d_out; p.ws = (unsigned char*)d_ws;
    p.lg0 = (float)log1p(-exp2(-5.0)); p.lg1 = (float)log1p(-exp2(-6.0)); p.lg2 = (float)log1p(-exp2(-7.0)); p.lg3 = (float)log1p(-exp2(-8.0));
    if (hipMemsetAsync((char*)d_ws + WS_BAR, 0, 16384, stream) != hipSuccess) { fprintf(stderr, "kernel_launch: memset of barrier words failed\n"); return; }
#if COOP_LAUNCH
    p.ph_lo = 0; p.ph_hi = NPHASE; p.coop = 1;
    void* args[] = {&p};
    hipError_t e = hipLaunchCooperativeKernel((const void*)hymba_mega, dim3(grid), dim3(512), args, LDS_BYTES, stream);
    if (e != hipSuccess) fprintf(stderr, "cooperative launch failed: %s (grid %d)\n", hipGetErrorString(e), grid);
#else
    for (int ph = 0; ph < NPHASE; ++ph) {
        p.ph_lo = ph; p.ph_hi = ph + 1; p.coop = 0;
        hipLaunchKernelGGL(hymba_mega, dim3(grid), dim3(512), LDS_BYTES, stream, p);
    }
#endif
}
```

```cpp
#include <hip/hip_runtime.h>
#include <hip/hip_cooperative_groups.h>
#include <cstdio>
#include <cmath>
#include <cstring>
namespace cg = cooperative_groups;

#ifndef COOP_LAUNCH
#define COOP_LAUNCH 1
#endif

#define LAS __attribute__((address_space(3)))
typedef unsigned short bf16_t;
typedef short bf16x8 __attribute__((ext_vector_type(8)));
typedef float f32x4 __attribute__((ext_vector_type(4)));
typedef unsigned u32x4 __attribute__((ext_vector_type(4)));
typedef unsigned u32x2 __attribute__((ext_vector_type(2)));

constexpr int DM = 2048, NBATCH = 4, SEQL = 2048, NMETA = 16, LP = SEQL + NMETA, DECB = 128;
constexpr int MMAIN = NBATCH * SEQL;
constexpr int SROW0 = MMAIN;
constexpr int MROW0 = SROW0 + DECB;
constexpr int MTOT = MROW0 + NMETA;
constexpr int MOUT = MROW0;
constexpr int MPAD = 8448;
constexpr int CONVD = 1536, DFF = 5632, PROJD = 6672, PROJP = 6912;
constexpr int OZ = 0, OX = 1024, OB = 2048, OC = 2304, ODT = 2560, OQ = 2576, OKK = 3600, OV = 4624, OG = 5648;
constexpr int NSTEP = 33;
constexpr int TABROWS = LP + 1;
constexpr float EPS = 1e-6f;

constexpr size_t WS_WIN = 0;
constexpr size_t WS_WOUT = WS_WIN + (size_t)PROJP * DM * 2;
constexpr size_t WS_WGU = WS_WOUT + (size_t)DM * DM * 2;
constexpr size_t WS_WDN = WS_WGU + (size_t)2 * DFF * DM * 2;
constexpr size_t WS_ABUF = WS_WDN + (size_t)DM * DFF * 2;
constexpr size_t WS_PROJ = WS_ABUF + (size_t)MPAD * DM * 2;
constexpr size_t WS_TMP = WS_PROJ + (size_t)MPAD * PROJP * 2;
constexpr size_t WS_H1 = WS_TMP + (size_t)MPAD * DM * 4;
constexpr size_t WS_TAB = WS_H1 + (size_t)MPAD * DM * 4;
constexpr size_t WS_XC = WS_TAB + (size_t)TABROWS * 256 * 4;
constexpr size_t WS_AUX2 = WS_XC + (size_t)MPAD * CONVD * 2;
constexpr size_t WS_BAR = WS_AUX2 + (size_t)2 * DECB * DM * 4;
constexpr size_t WS_END = WS_BAR + 16384;

constexpr size_t O_YP = 0;
constexpr size_t O_YS = O_YP + (size_t)NBATCH * SEQL * DM;
constexpr size_t O_PCONV = O_YS + (size_t)DECB * DM;
constexpr size_t O_PSSM = O_PCONV + (size_t)NBATCH * 3 * CONVD;
constexpr size_t O_PRET = O_PSSM + (size_t)NBATCH * 16 * 64 * 128;
constexpr size_t O_SCONV = O_PRET + (size_t)NBATCH * 4 * 256 * 256;
constexpr size_t O_SSSM = O_SCONV + (size_t)DECB * 3 * CONVD;
constexpr size_t O_SRET = O_SSSM + (size_t)DECB * 16 * 64 * 128;
constexpr size_t O_END = O_SRET + (size_t)DECB * 4 * 256 * 256;

constexpr int LDS_ST = 135168;
constexpr int LDS_BYTES = LDS_ST + 16;
constexpr int NPHASE = 10;

struct Params {
    const float *x_prompt, *x_sample, *state_conv, *state_ssm, *state_ret, *meta, *pre_mix_g, *post_mix_g, *pre_ffn_g, *post_ffn_g,
        *w_in, *conv_w, *conv_b, *dt_bias, *a_log, *d_skip, *ssm_norm_g, *ret_norm_g, *w_out, *w_gate, *w_up, *w_down;
    float* out;
    unsigned char* ws;
    float lg0, lg1, lg2, lg3;
    int ph_lo, ph_hi, coop, pad;
};

__device__ __forceinline__ float bf2f(bf16_t b) { return __uint_as_float(((unsigned)b) << 16); }
typedef __bf16 nbf16x2 __attribute__((ext_vector_type(2)));
typedef float f32x2n __attribute__((ext_vector_type(2)));
__device__ __forceinline__ bf16_t f2bf(float f) { const __bf16 h = (__bf16)f; return __builtin_bit_cast(unsigned short, h); }
__device__ __forceinline__ unsigned pack2(float a, float b) { const f32x2n v = {a, b}; const nbf16x2 h = __builtin_convertvector(v, nbf16x2); return __builtin_bit_cast(unsigned, h); }
__device__ __forceinline__ float lo16(unsigned u) { return __uint_as_float(u << 16); }
__device__ __forceinline__ float hi16(unsigned u) { return __uint_as_float(u & 0xffff0000u); }
__device__ __forceinline__ float4 ld4bf(const bf16_t* p) { const u32x2 u = *(const u32x2*)p; return make_float4(lo16(u.x), hi16(u.x), lo16(u.y), hi16(u.y)); }
__device__ __forceinline__ float silu_f(float x) { return x * __builtin_amdgcn_rcpf(1.0f + __expf(-x)); }
__device__ __forceinline__ float softplus_f(float x) { return fmaxf(x, 0.0f) + log1pf(__expf(-fabsf(x))); }
__device__ __forceinline__ float wave_sum(float v) {
#pragma unroll
    for (int o = 32; o >= 1; o >>= 1) v += __shfl_xor(v, o);
    return v;
}
__device__ __forceinline__ void lds_barrier() { asm volatile("s_waitcnt lgkmcnt(0)\n\ts_barrier" ::: "memory"); }
__device__ __forceinline__ unsigned cvt_pk_bf16(float lo, float hi) { unsigned r; asm volatile("v_cvt_pk_bf16_f32 %0, %1, %2" : "=v"(r) : "v"(lo), "v"(hi)); return r; }

__device__ __forceinline__ const float* src_row(const Params& p, int row) {
    if (row < MMAIN) return p.x_prompt + (size_t)row * DM;
    if (row < MROW0) return p.x_sample + (size_t)(row - SROW0) * DM;
    return p.meta + (size_t)(row - MROW0) * DM;
}
__device__ __forceinline__ int prow(int b, int t) { return t < NMETA ? MROW0 + t : b * SEQL + t - NMETA; }

template <int K>
__device__ __forceinline__ void mma16(f32x4& acc, const LAS bf16_t* A, int lda, const LAS bf16_t* Bt, int ldb, int fr, int fq) {
    const LAS bf16_t* ap = A + fr * lda + fq * 8; const LAS bf16_t* bp = Bt + fr * ldb + fq * 8;
#pragma unroll 1
    for (int k0 = 0; k0 < K; k0 += 64) {
#pragma unroll
        for (int k1 = 0; k1 < 64; k1 += 32) {
            const bf16x8 a = *(const LAS bf16x8*)(ap + k0 + k1);
            const bf16x8 b = *(const LAS bf16x8*)(bp + k0 + k1);
            acc = __builtin_amdgcn_mfma_f32_16x16x32_bf16(a, b, acc, 0, 0, 0);
        }
    }
}

template <int K>
__device__ __forceinline__ void mma16x3(f32x4& c0, f32x4& c1, f32x4& c2, const LAS bf16_t* A, const LAS bf16_t* B0, const LAS bf16_t* B1, const LAS bf16_t* B2, int ld, int fr, int fq) {
    const int off = fr * ld + fq * 8;
    const LAS bf16_t* ap = A + off; const LAS bf16_t* p0 = B0 + off; const LAS bf16_t* p1 = B1 + off; const LAS bf16_t* p2 = B2 + off;
#pragma unroll 1
    for (int k0 = 0; k0 < K; k0 += 128) {
#pragma unroll
        for (int k1 = 0; k1 < 128; k1 += 32) {
            const bf16x8 a = *(const LAS bf16x8*)(ap + k0 + k1);
            const bf16x8 x0 = *(const LAS bf16x8*)(p0 + k0 + k1), x1 = *(const LAS bf16x8*)(p1 + k0 + k1), x2 = *(const LAS bf16x8*)(p2 + k0 + k1);
            c0 = __builtin_amdgcn_mfma_f32_16x16x32_bf16(a, x0, c0, 0, 0, 0);
            c1 = __builtin_amdgcn_mfma_f32_16x16x32_bf16(a, x1, c1, 0, 0, 0);
            c2 = __builtin_amdgcn_mfma_f32_16x16x32_bf16(a, x2, c2, 0, 0, 0);
        }
    }
}
typedef short s16x4 __attribute__((ext_vector_type(4)));
__device__ __forceinline__ bf16x8 ld_row(const LAS bf16_t* M, int ld, int k0, int fr, int fq) { return *(const LAS bf16x8*)(M + fr * ld + k0 + fq * 8); }
__device__ __forceinline__ bf16x8 ld_tr(const LAS bf16_t* M, int ld, int k0, int fr, int fq) {
    const LAS bf16_t* a = M + (k0 + 8 * fq + (fr >> 2)) * ld + 4 * (fr & 3);
    const s16x4 lo = __builtin_amdgcn_ds_read_tr16_b64_v4i16((LAS s16x4*)a);
    const s16x4 hi = __builtin_amdgcn_ds_read_tr16_b64_v4i16((LAS s16x4*)(a + 4 * ld));
    return (bf16x8){lo[0], lo[1], lo[2], lo[3], hi[0], hi[1], hi[2], hi[3]};
}
#define MFMA16(a, b, c) __builtin_amdgcn_mfma_f32_16x16x32_bf16(a, b, c, 0, 0, 0)

#define XB_TMO      128
#define XB_XCNT(j)  (256  + 64 * (j))
#define XB_XSUB(j)  (1280 + 64 * (j))
#define XB_XGEN(j)  (2304 + 64 * (j))
#define XB_TOP      3328
#define XB_TOPGEN   3392
#define XCD_BAR_WORDS 3456
#define XB_SPIN_CAP (1u << 18)
__device__ __forceinline__ unsigned xb_ld(unsigned* p)              { return __hip_atomic_load(p, __ATOMIC_RELAXED, __HIP_MEMORY_SCOPE_AGENT); }
__device__ __forceinline__ unsigned xb_add(unsigned* p, unsigned v) { return __hip_atomic_fetch_add(p, v, __ATOMIC_RELAXED, __HIP_MEMORY_SCOPE_AGENT); }
__device__ __forceinline__ unsigned xb_xcc_id() { return (unsigned)__builtin_amdgcn_s_getreg((3 << 11) | 20) & 0xFu; }
#define XB_SPIN(cond, bar) do { unsigned _sp = 0; while (cond) { __builtin_amdgcn_s_sleep(1); \
    if ((++_sp & 255u) == 0u) { if (xb_ld(&(bar)[XB_TMO])) break; if (_sp > XB_SPIN_CAP) { atomicAdd(&(bar)[XB_TMO], 1u); break; } } } } while (0)
struct XcdBarrier { unsigned* bar; unsigned x; volatile LAS unsigned* st; };
__device__ __forceinline__ XcdBarrier xcd_barrier_post(unsigned* bar, volatile LAS unsigned* st) {
    XcdBarrier b; b.bar = bar; b.x = xb_xcc_id(); b.st = st;
    if (threadIdx.x == 0) (void)xb_add(&bar[XB_XCNT(b.x)], 1u);
    return b;
}
__device__ __forceinline__ void xcd_barrier_complete(unsigned* bar, unsigned x, unsigned& nloc, unsigned& nx) {
    const unsigned G = gridDim.x * gridDim.y * gridDim.z;
    unsigned sum, cnt, mine, sp = 0u;
    for (;;) {
        sum = 0u; cnt = 0u; mine = 0u;
#pragma unroll
        for (unsigned j = 0; j < 16; ++j) { const unsigned c = xb_ld(&bar[XB_XCNT(j)]); sum += c; cnt += (c > 0u) ? 1u : 0u; mine = (j == x) ? c : mine; }
        if (sum == G) break;
        __builtin_amdgcn_s_sleep(1);
        if ((++sp & 255u) == 0u) { if (xb_ld(&bar[XB_TMO])) break; if (sp > XB_SPIN_CAP) { atomicAdd(&bar[XB_TMO], 1u); break; } }
    }
    nloc = mine > 0u ? mine : 1u; nx = cnt > 0u ? cnt : 1u;
}
__device__ __forceinline__ void xcd_barrier(const XcdBarrier& b) {
    asm volatile("s_waitcnt vmcnt(0)" ::: "memory");
    __syncthreads();
    if (threadIdx.x == 0) {
        unsigned* bar = b.bar;
        __builtin_amdgcn_s_waitcnt(0);
        unsigned nloc = b.st[0], nx = b.st[1];
        if (nloc == 0u) { xcd_barrier_complete(bar, b.x, nloc, nx); b.st[0] = nloc; b.st[1] = nx; }
        const unsigned old = xb_add(&bar[XB_XSUB(b.x)], 1u);
        const unsigned gen = old / nloc;
        if (old + 1u == (gen + 1u) * nloc) {
            __builtin_amdgcn_fence(__ATOMIC_RELEASE, "agent");
            asm volatile("s_waitcnt vmcnt(0)" ::: "memory");
            const unsigned og = xb_add(&bar[XB_TOP], 1u);
            const unsigned tg = og / nx;
            if (og + 1u == (tg + 1u) * nx) xb_add(&bar[XB_TOPGEN], 1u);
            else XB_SPIN(xb_ld(&bar[XB_TOPGEN]) == tg, bar);
            __builtin_amdgcn_fence(__ATOMIC_ACQUIRE, "agent");
            xb_add(&bar[XB_XGEN(b.x)], 1u);
            asm volatile("s_waitcnt vmcnt(0)" ::: "memory");
        } else {
            XB_SPIN(xb_ld(&bar[XB_XGEN(b.x)]) == gen, bar);
            __builtin_amdgcn_fence(__ATOMIC_ACQUIRE, "agent");
            asm volatile("s_waitcnt vmcnt(0)" ::: "memory");
        }
    }
    __syncthreads();
}

namespace pg8 {
constexpr int BM = 256, BK = 64, HALF = 128, HTB = HALF * BK * 2, STAGE_BYTES = 8 * HTB, NXCD = 8, WGM = 8;
__host__ __device__ __forceinline__ int lds_byte(int r, int c) { const int st = (r >> 4) * 2 + (c >> 5), rr = r & 15, cc = c & 31, ob = rr * 64 + cc * 2; return st * 1024 + (ob ^ (((ob >> 9) & 1) << 5)); }
__host__ __device__ __forceinline__ void stage_rc(int b, int& R, int& C) { const int st = b / 1024, sb = b % 1024, swz = sb ^ (((sb >> 9) & 1) << 5); R = (st >> 1) * 16 + swz / 64; C = (st & 1) * 32 + (swz % 64) / 2; }
__host__ __device__ __forceinline__ int perm32(int rho) { const int n = rho >> 4, i = rho & 15; return 8 * (i >> 2) + 4 * n + (i & 3); }
struct Unit { int pm, pn; };
struct Gemm { const bf16_t* A; const bf16_t* Bt; int M, N, K; };
struct StaticOrder {
    int nM, nN, nwg, G, c;
    __host__ __device__ void init(int M, int N, int G_, int c_) { nM = M / BM; nN = N / BM; nwg = nM * nN; G = G_; c = c_; }
    __host__ __device__ bool next(int i, Unit& u) const {
        const long L = (long)i * G + c; if (L >= nwg) return false;
        int wgid = (int)L; { const int q = nwg / NXCD, r = nwg % NXCD, xcd = wgid % NXCD, off = wgid / NXCD; wgid = (xcd < r ? xcd * (q + 1) : r * (q + 1) + (xcd - r) * q) + off; }
        const int nig = WGM * nN, gid = wgid / nig, fm = gid * WGM, gsz = (nM - fm) < WGM ? (nM - fm) : WGM;
        u.pm = fm + ((wgid % nig) % gsz); u.pn = (wgid % nig) / gsz; return true;
    }
};

struct EpiF32 {
    static constexpr bool PERM = false;
    float* C; int ldc;
    __device__ __forceinline__ void operator()(const f32x4 (&acc)[2][2][4][2], const Unit& u, int wr, int wc, int fr, int fq) const {
        const int row0 = u.pm * BM + wr * 64 + fr, col0 = u.pn * BM + wc * 32 + 4 * fq;
#pragma unroll
        for (int ai = 0; ai < 2; ++ai)
#pragma unroll
            for (int m = 0; m < 4; ++m) { float* rowp = C + (size_t)(row0 + ai * HALF + m * 16) * ldc + col0;
#pragma unroll
                for (int bj = 0; bj < 2; ++bj)
#pragma unroll
                    for (int n = 0; n < 2; ++n) *(f32x4*)(rowp + bj * HALF + n * 16) = acc[ai][bj][m][n]; }
    }
};
struct EpiBf16 {
    static constexpr bool PERM = true;
    bf16_t* O; int ldc;
    __device__ __forceinline__ void operator()(const f32x4 (&acc)[2][2][4][2], const Unit& u, int wr, int wc, int fr, int fq) const {
        const int row0 = u.pm * BM + wr * 64 + fr, col0 = u.pn * BM + wc * 32 + 8 * fq;
#pragma unroll
        for (int ai = 0; ai < 2; ++ai)
#pragma unroll
            for (int m = 0; m < 4; ++m) { bf16_t* rowp = O + (size_t)(row0 + ai * HALF + m * 16) * ldc + col0;
#pragma unroll
                for (int bj = 0; bj < 2; ++bj) { const f32x4 v0 = acc[ai][bj][m][0], v1 = acc[ai][bj][m][1];
                    u32x4 w; w.x = cvt_pk_bf16(v0[0], v0[1]); w.y = cvt_pk_bf16(v0[2], v0[3]); w.z = cvt_pk_bf16(v1[0], v1[1]); w.w = cvt_pk_bf16(v1[2], v1[3]);
                    *(u32x4*)(rowp + bj * HALF) = w; } }
    }
};
struct EpiSwiGLU {
    static constexpr bool PERM = true;
    bf16_t* O; int ldc;
    __device__ __forceinline__ void operator()(const f32x4 (&acc)[2][2][4][2], const Unit& u, int wr, int wc, int fr, int fq) const {
        const int row0 = u.pm * BM + wr * 64 + fr, col0 = u.pn * HALF + wc * 32 + 8 * fq;
#pragma unroll
        for (int ai = 0; ai < 2; ++ai)
#pragma unroll
            for (int m = 0; m < 4; ++m) { bf16_t* rowp = O + (size_t)(row0 + ai * HALF + m * 16) * ldc + col0;
                float o[8];
#pragma unroll
                for (int n = 0; n < 2; ++n)
#pragma unroll
                    for (int j = 0; j < 4; ++j) { const float g = acc[ai][0][m][n][j], up = acc[ai][1][m][n][j]; o[n * 4 + j] = g * __builtin_amdgcn_rcpf(1.0f + __expf(-g)) * up; }
                u32x4 w; w.x = cvt_pk_bf16(o[0], o[1]); w.y = cvt_pk_bf16(o[2], o[3]); w.z = cvt_pk_bf16(o[4], o[5]); w.w = cvt_pk_bf16(o[6], o[7]);
                *(u32x4*)(rowp) = w; }
    }
};

template <class Epi, class Sched>
__device__ __forceinline__ void gemm_phase(LAS unsigned char* lds, const Gemm g, const Sched& S, const Epi& E) {
    const int tid = threadIdx.x, wid = __builtin_amdgcn_readfirstlane(tid >> 6), lane = tid & 63, wr = wid >> 2, wc = wid & 3, fr = lane & 15, fq = lane >> 4;
    const int K = g.K, nt = K / BK;
    unsigned voffA[2], voffB[2];
#pragma unroll
    for (int i = 0; i < 2; ++i) { int R, C; stage_rc(tid * 16 + i * 8192, R, C); const int Rb = Epi::PERM ? ((R & ~31) + perm32(R & 31)) : R;
        voffA[i] = (unsigned)(R * K + C) * 2u; voffB[i] = (unsigned)(Rb * K + C) * 2u; }
    const size_t kstep = (size_t)(BK * 2);
    const size_t hstep = (size_t)HALF * K * 2;
    const size_t tstep = 2 * hstep;
    const unsigned ldsw = (unsigned)wid * 1024u;
    const int aoff = lds_byte(wr * 64 + fr, fq * 8), boff = lds_byte(wc * 32 + fr, fq * 8);
#define PG8_SA(b, h) (((b) * 2 + (h)) * HTB)
#define PG8_SB(b, h) ((4 + (b) * 2 + (h)) * HTB)
#define PG8_STAGE(bufoff, gbase, voff) do { _Pragma("unroll") for (int _i = 0; _i < 2; ++_i) \
        __builtin_amdgcn_global_load_lds((const unsigned*)((const char*)(gbase) + (voff)[_i]), (LAS unsigned*)(lds + (bufoff) + ldsw + _i * 8192), 16, 0, 0); } while (0)
#define PG8_LDA(dst, b, h) do { _Pragma("unroll") for (int m = 0; m < 4; ++m) _Pragma("unroll") for (int k = 0; k < 2; ++k) dst[m][k] = *(const LAS bf16x8*)(lds + PG8_SA(b, h) + aoff + m * 2048 + k * 1024); } while (0)
#define PG8_LDB(dst, b, h) do { _Pragma("unroll") for (int n = 0; n < 2; ++n) _Pragma("unroll") for (int k = 0; k < 2; ++k) dst[n][k] = *(const LAS bf16x8*)(lds + PG8_SB(b, h) + boff + n * 2048 + k * 1024); } while (0)
#define PG8_MMA(ai, bj, At, Bt) do { __builtin_amdgcn_s_setprio(1); _Pragma("unroll") for (int m = 0; m < 4; ++m) _Pragma("unroll") for (int n = 0; n < 2; ++n) _Pragma("unroll") for (int k = 0; k < 2; ++k) \
        acc[ai][bj][m][n] = __builtin_amdgcn_mfma_f32_16x16x32_bf16(Bt[n][k], At[m][k], acc[ai][bj][m][n], 0, 0, 0); __builtin_amdgcn_s_setprio(0); } while (0)
#define PG8_WAIT_V(n) asm volatile("s_waitcnt vmcnt(" #n ")" ::: "memory")
#define PG8_WAIT_L(n) asm volatile("s_waitcnt lgkmcnt(" #n ")" ::: "memory")
#define PG8_BAR __builtin_amdgcn_s_barrier()
#define PG8_SCHED __builtin_amdgcn_sched_barrier(0)
    Unit cur, nxt; int ui = 0;
    if (!S.next(0, cur)) return;
    f32x4 acc[2][2][4][2];
#pragma unroll
    for (int a = 0; a < 2; ++a)
#pragma unroll
        for (int b = 0; b < 2; ++b)
#pragma unroll
            for (int m = 0; m < 4; ++m)
#pragma unroll
                for (int n = 0; n < 2; ++n) acc[a][b][m][n] = (f32x4){0.f, 0.f, 0.f, 0.f};
    bf16x8 At[4][2], B0[2][2], B1[2][2];
    const char* cA = (const char*)g.A + (size_t)cur.pm * tstep; const char* cB = (const char*)g.Bt + (size_t)cur.pn * tstep;
    PG8_STAGE(PG8_SB(0, 0), cB, voffB); PG8_STAGE(PG8_SA(0, 0), cA, voffA); PG8_STAGE(PG8_SB(0, 1), cB + hstep, voffB); PG8_STAGE(PG8_SA(0, 1), cA + hstep, voffA);
    if (wr == 1) PG8_BAR;
    PG8_WAIT_V(4); PG8_BAR;
    PG8_STAGE(PG8_SB(1, 0), cB + kstep, voffB); PG8_STAGE(PG8_SA(1, 0), cA + kstep, voffA); PG8_STAGE(PG8_SB(1, 1), cB + hstep + kstep, voffB);
    PG8_WAIT_V(6); PG8_BAR;
    for (;;) {
        const bool has_next = S.next(ui + 1, nxt);
        const char* nA = has_next ? (const char*)g.A + (size_t)nxt.pm * tstep : cA; const char* nB = has_next ? (const char*)g.Bt + (size_t)nxt.pn * tstep : cB;
        for (int t = 0; t < nt; t += 2) {
            const bool last = (t == nt - 2);
            const char* a1 = cA + (size_t)(t + 1) * kstep;
            const char* a2 = last ? nA : cA + (size_t)(t + 2) * kstep; const char* b2 = last ? nB : cB + (size_t)(t + 2) * kstep;
            const char* a3 = a2 + kstep; const char* b3 = b2 + kstep;
            PG8_LDB(B0, 0, 0); PG8_SCHED; PG8_LDA(At, 0, 0); PG8_STAGE(PG8_SA(1, 1), a1 + hstep, voffA);
            PG8_WAIT_L(8); PG8_BAR; PG8_WAIT_L(0); PG8_MMA(0, 0, At, B0); PG8_BAR; PG8_SCHED;
            PG8_LDB(B1, 0, 1); PG8_STAGE(PG8_SB(0, 0), b2, voffB);
            PG8_BAR; PG8_WAIT_L(0); PG8_MMA(0, 1, At, B1); PG8_BAR;
            PG8_LDA(At, 0, 1); PG8_STAGE(PG8_SA(0, 0), a2, voffA);
            PG8_BAR; PG8_WAIT_L(0); PG8_MMA(1, 0, At, B0); PG8_BAR; PG8_SCHED;
            PG8_STAGE(PG8_SB(0, 1), b2 + hstep, voffB);
            PG8_WAIT_V(6); PG8_BAR; PG8_MMA(1, 1, At, B1); PG8_BAR;
            PG8_LDB(B0, 1, 0); PG8_SCHED; PG8_LDA(At, 1, 0); PG8_STAGE(PG8_SA(0, 1), a2 + hstep, voffA);
            PG8_WAIT_L(8); PG8_BAR; PG8_WAIT_L(0); PG8_MMA(0, 0, At, B0); PG8_BAR; PG8_SCHED;
            PG8_LDB(B1, 1, 1); PG8_STAGE(PG8_SB(1, 0), b3, voffB);
            PG8_BAR; PG8_WAIT_L(0); PG8_MMA(0, 1, At, B1); PG8_BAR;
            PG8_LDA(At, 1, 1); PG8_STAGE(PG8_SA(1, 0), a3, voffA);
            PG8_BAR; PG8_WAIT_L(0); PG8_MMA(1, 0, At, B0); PG8_BAR; PG8_SCHED;
            PG8_STAGE(PG8_SB(1, 1), b3 + hstep, voffB);
            PG8_WAIT_V(6); PG8_BAR; PG8_MMA(1, 1, At, B1); PG8_BAR;
        }
        E(acc, cur, wr, wc, fr, fq);
        if (!has_next) break;
#pragma unroll
        for (int a = 0; a < 2; ++a)
#pragma unroll
            for (int b = 0; b < 2; ++b)
#pragma unroll
                for (int m = 0; m < 4; ++m)
#pragma unroll
                    for (int n = 0; n < 2; ++n) acc[a][b][m][n] = (f32x4){0.f, 0.f, 0.f, 0.f};
        cur = nxt; cA = nA; cB = nB; ++ui;
    }
    PG8_WAIT_V(0);
    if (wr == 0) PG8_BAR;
    PG8_BAR;
#undef PG8_SA
#undef PG8_SB
#undef PG8_STAGE
#undef PG8_LDA
#undef PG8_LDB
#undef PG8_MMA
#undef PG8_WAIT_V
#undef PG8_WAIT_L
#undef PG8_BAR
#undef PG8_SCHED
}
}

struct WJob { const float* W; bf16_t* dst; int N, K, k0, n0, rowmode; };
constexpr int WT0 = 32 * 27, WT1 = WT0 + 32 * 8, WT2 = WT1 + 32 * 22, WT3 = WT2 + 32 * 22, WT4 = WT3 + 88 * 8;
__device__ __forceinline__ WJob wjob(const Params& p, int t) {
    WJob j;
    if (t < WT0) { j.W = p.w_in; j.dst = (bf16_t*)(p.ws + WS_WIN); j.N = PROJD; j.K = DM; j.k0 = (t / 27) * 64; j.n0 = (t % 27) * 256; j.rowmode = 0; }
    else if (t < WT1) { const int u = t - WT0; j.W = p.w_out; j.dst = (bf16_t*)(p.ws + WS_WOUT); j.N = DM; j.K = DM; j.k0 = (u / 8) * 64; j.n0 = (u % 8) * 256; j.rowmode = 0; }
    else if (t < WT2) { const int u = t - WT1; j.W = p.w_gate; j.dst = (bf16_t*)(p.ws + WS_WGU); j.N = DFF; j.K = DM; j.k0 = (u / 22) * 64; j.n0 = (u % 22) * 256; j.rowmode = 1; }
    else if (t < WT3) { const int u = t - WT2; j.W = p.w_up; j.dst = (bf16_t*)(p.ws + WS_WGU); j.N = DFF; j.K = DM; j.k0 = (u / 22) * 64; j.n0 = (u % 22) * 256; j.rowmode = 2; }
    else { const int u = t - WT3; j.W = p.w_down; j.dst = (bf16_t*)(p.ws + WS_WDN); j.N = DM; j.K = DFF; j.k0 = (u / 8) * 64; j.n0 = (u % 8) * 256; j.rowmode = 0; }
    return j;
}
__device__ __forceinline__ void wload(const WJob& j, f32x4 (&v)[8]) {
    const int tid = threadIdx.x, kk = tid >> 6, n = j.n0 + 4 * (tid & 63);
#pragma unroll
    for (int it = 0; it < 8; ++it) { v[it] = (f32x4){0.f, 0.f, 0.f, 0.f};
        if (n < j.N) v[it] = __builtin_nontemporal_load((const f32x4*)(j.W + (size_t)(j.k0 + kk + 8 * it) * j.N + n)); }
}
__device__ void weights_pass(const Params& p, LAS unsigned char* lds, int t_begin, int t_end, int worker, int nworkers) {
    LAS unsigned* tw = (LAS unsigned*)lds;
    const LAS bf16_t* th = (const LAS bf16_t*)lds;
    const int tid = threadIdx.x, kk = tid >> 6, n4 = tid & 63;
    int t = t_begin + worker;
    if (t >= t_end) return;
    f32x4 v[8];
    WJob cur = wjob(p, t);
    wload(cur, v);
    for (;;) {
#pragma unroll
        for (int it = 0; it < 8; ++it) { const int k = kk + 8 * it;
            tw[k * 129 + 2 * n4] = cvt_pk_bf16(v[it][0], v[it][1]); tw[k * 129 + 2 * n4 + 1] = cvt_pk_bf16(v[it][2], v[it][3]); }
        __syncthreads();
        const int tn = t + nworkers; const bool more = tn < t_end;
        WJob nxt = cur;
        if (more) { nxt = wjob(p, tn); wload(nxt, v); }
#pragma unroll
        for (int jj = 0; jj < 4; ++jj) {
            const int c = tid + 512 * jj, k8 = c & 7, nl = c >> 3, n = cur.n0 + nl;
            unsigned short e[8];
#pragma unroll
            for (int q = 0; q < 8; ++q) e[q] = th[(8 * k8 + q) * 258 + nl];
            if (n < cur.N) {
                int nr = n;
                if (cur.rowmode == 1) nr = 256 * (n >> 7) + (n & 127);
                else if (cur.rowmode == 2) nr = 256 * (n >> 7) + 128 + (n & 127);
                u32x4 w; w.x = (unsigned)e[0] | ((unsigned)e[1] << 16); w.y = (unsigned)e[2] | ((unsigned)e[3] << 16); w.z = (unsigned)e[4] | ((unsigned)e[5] << 16); w.w = (unsigned)e[6] | ((unsigned)e[7] << 16);
                *(u32x4*)(cur.dst + (size_t)nr * cur.K + cur.k0 + 8 * k8) = w;
            }
        }
        if (!more) break;
        __syncthreads();
        cur = nxt; t = tn;
    }
    __syncthreads();
}

__device__ void phase_prep(const Params& p, LAS unsigned char* lds) {
    const int tid = threadIdx.x, wid = tid >> 6, lane = tid & 63;
    bf16_t* win = (bf16_t*)(p.ws + WS_WIN);
    weights_pass(p, lds, 0, WT0, blockIdx.x, gridDim.x);
    const size_t gt = (size_t)blockIdx.x * 512 + tid, ngt = (size_t)gridDim.x * 512;
    {
        u32x4 z = {0u, 0u, 0u, 0u};
        u32x4* a = (u32x4*)(win + (size_t)PROJD * DM); const size_t na = (size_t)(PROJP - PROJD) * DM * 2 / 16;
        for (size_t i = gt; i < na; i += ngt) a[i] = z;
        u32x4* b = (u32x4*)((bf16_t*)(p.ws + WS_ABUF) + (size_t)MTOT * DM); const size_t nb = (size_t)(MPAD - MTOT) * DM * 2 / 16;
        for (size_t i = gt; i < nb; i += ngt) b[i] = z;
    }
    {
        float* tab = (float*)(p.ws + WS_TAB);
        for (size_t i = gt; i < (size_t)TABROWS * 128; i += ngt) {
            const int pi = (int)(i >> 7), f = (int)(i & 127);
            const float pos = pi < LP ? (float)pi : 16384.0f;
            const float inv = exp2f(-(float)f * (13.287712379549449f / 128.0f));
            const float ang = pos * inv;
            const double a = (double)ang;
            const double n = rint(a * 0.15915494309189535);
            double r = fma(-n, 6.283185307179586, a); r = fma(-n, 2.4492935982947064e-16, r);
            const float rf = (float)r;
            tab[(size_t)pi * 256 + f] = cosf(rf); tab[(size_t)pi * 256 + 128 + f] = sinf(rf);
        }
    }
    {
        bf16_t* U = (bf16_t*)(p.ws + WS_ABUF);
        for (int row = blockIdx.x * 8 + wid; row < MTOT; row += gridDim.x * 8) {
            const float* x = src_row(p, row);
            float4 v[8]; float ss = 0.f;
#pragma unroll
            for (int q = 0; q < 8; ++q) { v[q] = *(const float4*)(x + q * 256 + lane * 4); ss += v[q].x * v[q].x + v[q].y * v[q].y + v[q].z * v[q].z + v[q].w * v[q].w; }
            ss = wave_sum(ss);
            const float rs = rsqrtf(ss * (1.0f / DM) + EPS);
#pragma unroll
            for (int q = 0; q < 8; ++q) { const int col = q * 256 + lane * 4; const float4 g = *(const float4*)(p.pre_mix_g + col);
                u32x2 w; w.x = pack2(v[q].x * rs * g.x, v[q].y * rs * g.y); w.y = pack2(v[q].z * rs * g.z, v[q].w * rs * g.w);
                *(u32x2*)(U + (size_t)row * DM + col) = w; }
        }
    }
}

__device__ void phase_convrope(const Params& p) {
    const bf16_t* __restrict__ proj = (const bf16_t*)(p.ws + WS_PROJ);
    bf16_t* projw = (bf16_t*)(p.ws + WS_PROJ);
    bf16_t* __restrict__ XC = (bf16_t*)(p.ws + WS_XC);
    const float* __restrict__ tab = (const float*)(p.ws + WS_TAB);
    const unsigned gt = blockIdx.x * 512 + threadIdx.x, ngt = gridDim.x * 512;
#pragma unroll 2
    for (unsigned i = gt; i < (unsigned)(NBATCH * 516 * 192); i += ngt) {
        const int oct = i % 192, tg = (i / 192) % 516, b = i / (192 * 516), t0 = tg * 4, ch = oct * 8;
        if (t0 < NMETA && b > 0) continue;
        u32x4 rin[7];
#pragma unroll
        for (int rr = 0; rr < 7; ++rr) { const int t = t0 - 3 + rr;
            rin[rr] = (u32x4){0u, 0u, 0u, 0u};
            if (t >= 0) rin[rr] = *(const u32x4*)(proj + (unsigned)(prow(b, t) * PROJP + OX + ch)); }
        u32x4 o[4];
#pragma unroll
        for (int e2 = 0; e2 < 4; ++e2) {
            const float2 w0 = *(const float2*)(p.conv_w + 0 * CONVD + ch + 2 * e2), w1 = *(const float2*)(p.conv_w + 1 * CONVD + ch + 2 * e2);
            const float2 w2 = *(const float2*)(p.conv_w + 2 * CONVD + ch + 2 * e2), w3 = *(const float2*)(p.conv_w + 3 * CONVD + ch + 2 * e2);
            const float2 bb = *(const float2*)(p.conv_b + ch + 2 * e2);
#pragma unroll
            for (int r = 0; r < 4; ++r) {
                const float v0 = bb.x + w0.x * lo16(rin[r][e2]) + w1.x * lo16(rin[r + 1][e2]) + w2.x * lo16(rin[r + 2][e2]) + w3.x * lo16(rin[r + 3][e2]);
                const float v1 = bb.y + w0.y * hi16(rin[r][e2]) + w1.y * hi16(rin[r + 1][e2]) + w2.y * hi16(rin[r + 2][e2]) + w3.y * hi16(rin[r + 3][e2]);
                o[r][e2] = cvt_pk_bf16(silu_f(v0), silu_f(v1));
            }
        }
#pragma unroll
        for (int r = 0; r < 4; ++r) *(u32x4*)(XC + (unsigned)(prow(b, t0 + r) * CONVD + ch)) = o[r];
    }
    for (unsigned i = gt; i < (unsigned)(DECB * 192); i += ngt) {
        const int s = i / 192, ch = (i % 192) * 8;
        const float* sc = p.state_conv + (size_t)s * 3 * CONVD + ch;
        const u32x4 cur = *(const u32x4*)(proj + (unsigned)((SROW0 + s) * PROJP + OX + ch));
        float* oc = p.out + O_SCONV + (size_t)s * 3 * CONVD + ch;
        u32x4 o;
#pragma unroll
        for (int e4 = 0; e4 < 2; ++e4) {
            const float4 i0 = *(const float4*)(sc + 4 * e4), i1 = *(const float4*)(sc + CONVD + 4 * e4), i2 = *(const float4*)(sc + 2 * CONVD + 4 * e4);
            const float4 i3 = make_float4(lo16(cur[2 * e4]), hi16(cur[2 * e4]), lo16(cur[2 * e4 + 1]), hi16(cur[2 * e4 + 1]));
            const float4 w0 = *(const float4*)(p.conv_w + ch + 4 * e4), w1 = *(const float4*)(p.conv_w + CONVD + ch + 4 * e4);
            const float4 w2 = *(const float4*)(p.conv_w + 2 * CONVD + ch + 4 * e4), w3 = *(const float4*)(p.conv_w + 3 * CONVD + ch + 4 * e4);
            const float4 bb = *(const float4*)(p.conv_b + ch + 4 * e4);
            const float v0 = bb.x + w0.x * i0.x + w1.x * i1.x + w2.x * i2.x + w3.x * i3.x, v1 = bb.y + w0.y * i0.y + w1.y * i1.y + w2.y * i2.y + w3.y * i3.y;
            const float v2 = bb.z + w0.z * i0.z + w1.z * i1.z + w2.z * i2.z + w3.z * i3.z, v3 = bb.w + w0.w * i0.w + w1.w * i1.w + w2.w * i2.w + w3.w * i3.w;
            o[2 * e4] = cvt_pk_bf16(silu_f(v0), silu_f(v1)); o[2 * e4 + 1] = cvt_pk_bf16(silu_f(v2), silu_f(v3));
            *(float4*)(oc + 4 * e4) = i1; *(float4*)(oc + CONVD + 4 * e4) = i2; *(float4*)(oc + 2 * CONVD + 4 * e4) = i3;
        }
        *(u32x4*)(XC + (unsigned)((SROW0 + s) * CONVD + ch)) = o;
    }
    for (unsigned i = gt; i < (unsigned)(MTOT * 64); i += ngt) {
        const int row = i >> 6, hd = (i >> 4) & 3, d8 = i & 15;
        const int trow = row < MMAIN ? (row & (SEQL - 1)) + NMETA : (row < MROW0 ? LP : row - MROW0);
        bf16_t* base = projw + (unsigned)(row * PROJP + hd * 256 + 8 * d8);
        const u32x4 q1 = *(const u32x4*)(base + OQ), q2 = *(const u32x4*)(base + OQ + 128), k1 = *(const u32x4*)(base + OKK), k2 = *(const u32x4*)(base + OKK + 128);
        const float* tp = tab + (unsigned)(trow * 256 + 8 * d8);
        const f32x4 c0 = *(const f32x4*)(tp), c1 = *(const f32x4*)(tp + 4), s0 = *(const f32x4*)(tp + 128), s1 = *(const f32x4*)(tp + 132);
        const float cc[8] = {c0[0], c0[1], c0[2], c0[3], c1[0], c1[1], c1[2], c1[3]}, sn[8] = {s0[0], s0[1], s0[2], s0[3], s1[0], s1[1], s1[2], s1[3]};
        u32x4 qlo, qhi, klo, khi;
#pragma unroll
        for (int e = 0; e < 4; ++e) {
            const float a0 = lo16(q1[e]), a1 = hi16(q1[e]), b0 = lo16(q2[e]), b1 = hi16(q2[e]);
            qlo[e] = cvt_pk_bf16(a0 * cc[2 * e] - b0 * sn[2 * e], a1 * cc[2 * e + 1] - b1 * sn[2 * e + 1]);
            qhi[e] = cvt_pk_bf16(a0 * sn[2 * e] + b0 * cc[2 * e], a1 * sn[2 * e + 1] + b1 * cc[2 * e + 1]);
            const float x0 = lo16(k1[e]), x1 = hi16(k1[e]), y0 = lo16(k2[e]), y1 = hi16(k2[e]);
            klo[e] = cvt_pk_bf16((x0 * cc[2 * e] - y0 * sn[2 * e]) * 0.0625f, (x1 * cc[2 * e + 1] - y1 * sn[2 * e + 1]) * 0.0625f);
            khi[e] = cvt_pk_bf16((x0 * sn[2 * e] + y0 * cc[2 * e]) * 0.0625f, (x1 * sn[2 * e + 1] + y1 * cc[2 * e + 1]) * 0.0625f);
        }
        *(u32x4*)(base + OQ) = qlo; *(u32x4*)(base + OQ + 128) = qhi; *(u32x4*)(base + OKK) = klo; *(u32x4*)(base + OKK + 128) = khi;
    }
    for (unsigned i = gt; i < (unsigned)(NBATCH * 3 * CONVD); i += ngt) {
        const int b = i / (3 * CONVD), r = (i / CONVD) % 3, c = i % CONVD;
        p.out[O_PCONV + i] = bf2f(proj[(unsigned)((b * SEQL + SEQL - 3 + r) * PROJP + OX + c)]);
    }
}

__device__ __forceinline__ int step_row(int b, int step, int i) { return step == 0 ? MROW0 + i : b * SEQL + 64 * (step - 1) + i; }

constexpr int SMP_OFF = 104448;
constexpr int SMP_XC = 0, SMP_ZV = 768, SMP_HP = 1280, SMP_Q = 1312, SMP_K = 1824, SMP_V = 2336, SMP_RED = 2848, SMP_FLOATS = 2848 + 2048;
constexpr int NSLICE = 24;
static_assert(SMP_OFF + SMP_FLOATS * 4 <= LDS_ST, "sample block does not fit");

__device__ __forceinline__ void sample_setup(const Params& p, LAS float* sm, int s, int hf) {
    const int tid = threadIdx.x;
    const bf16_t* prw = (const bf16_t*)(p.ws + WS_PROJ) + (size_t)(SROW0 + s) * PROJP;
    const bf16_t* xcr = (const bf16_t*)(p.ws + WS_XC) + (size_t)(SROW0 + s) * CONVD;
    for (int li = tid; li < 768; li += 512) {
        const int c = li < 512 ? hf * 512 + li : (li < 640 ? 1024 + hf * 128 + (li - 512) : 1280 + hf * 128 + (li - 640));
        sm[SMP_XC + li] = bf2f(xcr[c]);
    }
    sm[SMP_ZV + tid] = bf2f(prw[OZ + hf * 512 + tid]);
    if (tid < 8) { const int h = hf * 8 + tid;
        const float dt = softplus_f(bf2f(prw[ODT + h]) + p.dt_bias[h]);
        sm[SMP_HP + tid * 4 + 0] = dt; sm[SMP_HP + tid * 4 + 1] = __expf(-dt * __expf(p.a_log[h])); sm[SMP_HP + tid * 4 + 2] = p.d_skip[h]; }
    { const int r2 = tid >> 8, d = tid & 255, hd = hf * 2 + r2;
      sm[SMP_Q + tid] = bf2f(prw[OQ + hd * 256 + d]); sm[SMP_K + tid] = bf2f(prw[OKK + hd * 256 + d]); sm[SMP_V + tid] = bf2f(prw[OV + hd * 256 + d]); }
}
__device__ __forceinline__ void sample_issue(const Params& p, int s, int hf, int slice, f32x4 (&r)[4]) {
    const int tid = threadIdx.x;
    if (slice < 8) {
        const float* hin = p.state_ssm + ((size_t)s * 16 + hf * 8 + slice) * 64 * 128 + (size_t)(tid >> 5) * 128 + 4 * (tid & 31);
#pragma unroll
        for (int i = 0; i < 4; ++i) r[i] = __builtin_nontemporal_load((const f32x4*)(hin + (size_t)i * 16 * 128));
    } else {
        const int r2 = (slice - 8) >> 3, part = (slice - 8) & 7;
        const float* sin_ = p.state_ret + ((size_t)s * 4 + hf * 2 + r2) * 256 * 256 + (size_t)((tid >> 6) + 32 * part) * 256 + 4 * (tid & 63);
#pragma unroll
        for (int i = 0; i < 4; ++i) r[i] = __builtin_nontemporal_load((const f32x4*)(sin_ + (size_t)i * 8 * 256));
    }
}
__device__ __forceinline__ void sample_process(const Params& p, LAS float* sm, int s, int hf, int slice, const f32x4 (&r)[4], f32x4& ya) {
    const int tid = threadIdx.x;
    if (slice < 8) {
        const int n4 = tid & 31, pbase = tid >> 5, h = hf * 8 + slice;
        const f32x4 Bq = *(const LAS f32x4*)(sm + SMP_XC + 512 + 4 * n4), Cq = *(const LAS f32x4*)(sm + SMP_XC + 640 + 4 * n4);
        const float dt = sm[SMP_HP + slice * 4], dec = sm[SMP_HP + slice * 4 + 1], dsk = sm[SMP_HP + slice * 4 + 2];
        float* hout = p.out + O_SSSM + ((size_t)s * 16 + h) * 64 * 128 + (size_t)pbase * 128 + 4 * n4;
        bf16_t* Y = (bf16_t*)(p.ws + WS_TMP) + (size_t)(SROW0 + s) * DM;
        float yp[4], xs[4];
#pragma unroll
        for (int i = 0; i < 4; ++i) {
            const int pp = pbase + 16 * i;
            xs[i] = sm[SMP_XC + slice * 64 + pp];
            const float dx = dt * xs[i];
            const f32x4 hn = dec * r[i] + dx * Bq;
            *(f32x4*)(hout + (size_t)i * 16 * 128) = hn;
            yp[i] = Cq[0] * hn[0] + Cq[1] * hn[1] + Cq[2] * hn[2] + Cq[3] * hn[3];
        }
        const bool b4 = (n4 & 16) != 0, b3 = (n4 & 8) != 0;
        const float t0 = __shfl_xor(b4 ? yp[0] : yp[2], 16), t1 = __shfl_xor(b4 ? yp[1] : yp[3], 16);
        const float a0 = (b4 ? yp[2] : yp[0]) + t0, a1 = (b4 ? yp[3] : yp[1]) + t1;
        float bsum = (b3 ? a1 : a0) + __shfl_xor(b3 ? a0 : a1, 8);
        bsum += __shfl_xor(bsum, 4); bsum += __shfl_xor(bsum, 2); bsum += __shfl_xor(bsum, 1);
        if ((n4 & 7) == 0) {
            const int i = (b4 ? 2 : 0) + (b3 ? 1 : 0), pp = pbase + 16 * i;
            const float xv = b4 ? (b3 ? xs[3] : xs[2]) : (b3 ? xs[1] : xs[0]);
            Y[h * 64 + pp] = f2bf((bsum + dsk * xv) * silu_f(sm[SMP_ZV + slice * 64 + pp]));
        }
    } else {
        const int r2 = (slice - 8) >> 3, part = (slice - 8) & 7, hd = hf * 2 + r2, v4 = tid & 63, d0 = (tid >> 6) + 32 * part;
        const float gam = __expf(hd == 0 ? p.lg0 : hd == 1 ? p.lg1 : hd == 2 ? p.lg2 : p.lg3);
        const f32x4 vq = *(const LAS f32x4*)(sm + SMP_V + r2 * 256 + 4 * v4);
        float* sout = p.out + O_SRET + ((size_t)s * 4 + hd) * 256 * 256 + (size_t)d0 * 256 + 4 * v4;
        if (part == 0) ya = (f32x4){0.f, 0.f, 0.f, 0.f};
#pragma unroll
        for (int i = 0; i < 4; ++i) {
            const int d = d0 + 8 * i;
            const float kd = sm[SMP_K + r2 * 256 + d], qd = sm[SMP_Q + r2 * 256 + d];
            const f32x4 sn = gam * r[i] + kd * vq;
            __builtin_nontemporal_store(sn, (f32x4*)(sout + (size_t)i * 8 * 256));
            ya += qd * sn;
        }
        if (part == 7) *(LAS f32x4*)(sm + SMP_RED + (tid >> 6) * 256 + 4 * v4) = ya;
    }
}
__device__ __forceinline__ void sample_finalize(const Params& p, LAS float* sm, int s, int hf, int r2) {
    const int tid = threadIdx.x;
    if (tid < 256) { float a = 0.f;
#pragma unroll
        for (int w = 0; w < 8; ++w) a += sm[SMP_RED + w * 256 + tid];
        ((bf16_t*)(p.ws + WS_TMP))[(size_t)(SROW0 + s) * DM + 1024 + (hf * 2 + r2) * 256 + tid] = f2bf(a); }
}

__device__ void ret_task(const Params& p, LAS unsigned char* lds, int b, int hd, int sl, int smp, int shf) {
    const int tid = threadIdx.x, wid = tid >> 6, lane = tid & 63, fr = lane & 15, fq = lane >> 4;
    LAS bf16_t* Qs = (LAS bf16_t*)lds;
    LAS bf16_t* Ks = Qs + 64 * 264;
    LAS bf16_t* Ps = Ks + 64 * 264;
    LAS bf16_t* Vs = Ps + 64 * 72;
    LAS bf16_t* Vw = Vs + 64 * 40;
    LAS bf16_t* St = Vw + 64 * 40;
    const bf16_t* proj = (const bf16_t*)(p.ws + WS_PROJ);
    bf16_t* Y = (bf16_t*)(p.ws + WS_TMP);
    const float lg = hd == 0 ? p.lg0 : hd == 1 ? p.lg1 : hd == 2 ? p.lg2 : p.lg3;
    for (int i = tid; i < 32 * 264 / 2; i += 512) ((LAS unsigned*)St)[i] = 0u;
    f32x4 sacc[4];
#pragma unroll
    for (int i = 0; i < 4; ++i) sacc[i] = (f32x4){0.f, 0.f, 0.f, 0.f};
    u32x4 rq[4], rk[4], rv;
    const int crow = tid >> 5, cch = tid & 31, vrow = tid >> 2, v8 = tid & 3;
    auto issue = [&](int step) {
        const int nv = step == 0 ? NMETA : 64;
#pragma unroll
        for (int i = 0; i < 4; ++i) { const int row = crow + 16 * i;
            rq[i] = (u32x4){0u, 0u, 0u, 0u}; rk[i] = rq[i];
            if (row < nv) { const bf16_t* base = proj + (unsigned)(step_row(b, step, row) * PROJP + hd * 256 + 8 * cch);
                rq[i] = *(const u32x4*)(base + OQ); rk[i] = *(const u32x4*)(base + OKK); } }
        rv = (u32x4){0u, 0u, 0u, 0u};
        if (tid < 256 && vrow < nv) rv = *(const u32x4*)(proj + (unsigned)(step_row(b, step, vrow) * PROJP + OV + hd * 256 + sl * 32 + 8 * v8));
    };
    LAS float* sm = (LAS float*)(lds + SMP_OFF);
    sample_setup(p, sm, smp, shf);
    f32x4 sr[4]; f32x4 sya = {0.f, 0.f, 0.f, 0.f};
    issue(0);
    __syncthreads();
    for (int step = 0; step < NSTEP; ++step) {
        const int nv = step == 0 ? NMETA : 64;
#pragma unroll
        for (int i = 0; i < 4; ++i) { const int row = crow + 16 * i;
            *(LAS u32x4*)(Qs + row * 264 + 8 * cch) = rq[i]; *(LAS u32x4*)(Ks + row * 264 + 8 * cch) = rk[i]; }
        if (tid < 256) {
            const float wk = __expf((float)(nv - 1 - vrow) * lg);
            u32x4 vw;
#pragma unroll
            for (int e = 0; e < 4; ++e) vw[e] = pack2(lo16(rv[e]) * wk, hi16(rv[e]) * wk);
            *(LAS u32x4*)(Vs + vrow * 40 + 8 * v8) = rv; *(LAS u32x4*)(Vw + vrow * 40 + 8 * v8) = vw;
        }
        __syncthreads();
        if (step == 16 || step == 24) sample_finalize(p, sm, smp, shf, step == 16 ? 0 : 1);
        if (step + 1 < NSTEP) issue(step + 1);
        if (step < NSLICE) sample_issue(p, smp, shf, step, sr);
        const int ib = wid >> 1, vb = wid & 1;
        f32x4 acc3 = {0.f, 0.f, 0.f, 0.f};
        {
            f32x4 sc[2]; sc[0] = (f32x4){0.f, 0.f, 0.f, 0.f}; sc[1] = sc[0];
            const int jb0 = 2 * vb;
            mma16x3<256>(sc[0], sc[1], acc3, Qs + ib * 16 * 264, Ks + jb0 * 16 * 264, Ks + (jb0 + 1) * 16 * 264, St + vb * 16 * 264, 264, fr, fq);
#pragma unroll
            for (int tt = 0; tt < 2; ++tt) {
                const int jb = jb0 + tt;
#pragma unroll
                for (int r = 0; r < 4; ++r) { const int i = ib * 16 + fq * 4 + r, j = jb * 16 + fr;
                    const float val = (j <= i) ? sc[tt][r] * __expf((float)(i - j) * lg) : 0.f;
                    Ps[i * 72 + j] = f2bf(val); }
            }
        }
        __syncthreads();
        f32x4 acc2 = {0.f, 0.f, 0.f, 0.f};
#pragma unroll
        for (int k0 = 0; k0 < 64; k0 += 32) acc2 = MFMA16(ld_row(Ps + ib * 16 * 72, 72, k0, fr, fq), ld_tr(Vs + vb * 16, 40, k0, fr, fq), acc2);
        if (step > 0) {
#pragma unroll
            for (int r = 0; r < 4; ++r) { const int i = ib * 16 + fq * 4 + r;
                Y[(unsigned)(step_row(b, step, i) * DM + 1024 + hd * 256 + sl * 32 + vb * 16 + fr)] = f2bf(acc2[r] + __expf((float)(i + 1) * lg) * acc3[r]); }
        }
        const float dec = __expf((float)nv * lg);
#pragma unroll
        for (int tt = 0; tt < 4; ++tt) {
            const int db = 2 * wid + (tt >> 1), vb2 = tt & 1;
            sacc[tt] *= dec;
#pragma unroll
            for (int k0 = 0; k0 < 64; k0 += 32) sacc[tt] = MFMA16(ld_tr(Ks + db * 16, 264, k0, fr, fq), ld_tr(Vw + vb2 * 16, 40, k0, fr, fq), sacc[tt]);
        }
        if (step < NSLICE) sample_process(p, sm, smp, shf, step, sr, sya);
        __syncthreads();
#pragma unroll
        for (int tt = 0; tt < 4; ++tt) {
            const int db = 2 * wid + (tt >> 1), vb2 = tt & 1;
            u32x2 w; w.x = pack2(sacc[tt][0], sacc[tt][1]); w.y = pack2(sacc[tt][2], sacc[tt][3]);
            *(LAS u32x2*)(St + (vb2 * 16 + fr) * 264 + db * 16 + fq * 4) = w;
        }
    }
    float* o = p.out + O_PRET + (size_t)(b * 4 + hd) * 256 * 256;
#pragma unroll
    for (int tt = 0; tt < 4; ++tt) { const int db = 2 * wid + (tt >> 1), vb2 = tt & 1;
#pragma unroll
        for (int r = 0; r < 4; ++r) o[(size_t)(db * 16 + fq * 4 + r) * 256 + sl * 32 + vb2 * 16 + fr] = sacc[tt][r]; }
}

__device__ void ssd_task(const Params& p, LAS unsigned char* lds, int b, int h, int ph, int smp, int shf) {
    const int tid = threadIdx.x, wid = tid >> 6, lane = tid & 63, fr = lane & 15, fq = lane >> 4, g = h >> 3;
    LAS bf16_t* Cs = (LAS bf16_t*)lds;
    LAS bf16_t* Bs = Cs + 64 * 136;
    LAS bf16_t* Bw = Bs + 64 * 136;
    LAS bf16_t* Ps = Bw + 64 * 136;
    LAS bf16_t* Xs = Ps + 64 * 72;
    LAS bf16_t* Hs = Xs + 64 * 40;
    LAS float* dtA = (LAS float*)(Hs + 32 * 136);
    LAS float* lcA = dtA + NSTEP * 64;
    const bf16_t* proj = (const bf16_t*)(p.ws + WS_PROJ);
    const bf16_t* XC = (const bf16_t*)(p.ws + WS_XC);
    bf16_t* Y = (bf16_t*)(p.ws + WS_TMP);
    const float a_neg = -__expf(p.a_log[h]), dtb = p.dt_bias[h], dsk = p.d_skip[h];
    for (int step = wid; step < NSTEP; step += 8) {
        const int nv = step == 0 ? NMETA : 64;
        float dt = 0.f;
        if (lane < nv) dt = softplus_f(bf2f(proj[(unsigned)(step_row(b, step, lane) * PROJP + ODT + h)]) + dtb);
        float x = dt * a_neg;
#pragma unroll
        for (int o = 1; o < 64; o <<= 1) { const float y = __shfl_up(x, o); if (lane >= o) x += y; }
        dtA[step * 64 + lane] = dt; lcA[step * 64 + lane] = x;
    }
    for (int i = tid; i < 32 * 136 / 2; i += 512) ((LAS unsigned*)Hs)[i] = 0u;
    f32x4 hacc[2];
    hacc[0] = (f32x4){0.f, 0.f, 0.f, 0.f}; hacc[1] = hacc[0];
    u32x4 rb[2], rc[2], rx; bf16_t rz[4] = {0, 0, 0, 0};
    const int brow = tid >> 4, bch = tid & 15, xrow = tid >> 2, x8 = tid & 3;
    auto issue = [&](int step) {
        const int nv = step == 0 ? NMETA : 64;
#pragma unroll
        for (int i = 0; i < 2; ++i) { const int row = brow + 32 * i;
            rb[i] = (u32x4){0u, 0u, 0u, 0u}; rc[i] = rb[i];
            if (row < nv) { const bf16_t* base = XC + (unsigned)(step_row(b, step, row) * CONVD + g * 128 + 8 * bch);
                rb[i] = *(const u32x4*)(base + 1024); rc[i] = *(const u32x4*)(base + 1280); } }
        rx = (u32x4){0u, 0u, 0u, 0u};
        if (tid < 256 && xrow < nv) rx = *(const u32x4*)(XC + (unsigned)(step_row(b, step, xrow) * CONVD + h * 64 + ph * 32 + 8 * x8));
        if (step > 0) {
#pragma unroll
            for (int r = 0; r < 4; ++r) rz[r] = proj[(unsigned)(step_row(b, step, (wid >> 1) * 16 + fq * 4 + r) * PROJP + OZ + h * 64 + ph * 32 + (wid & 1) * 16 + fr)];
        }
    };
    LAS float* sm = (LAS float*)(lds + SMP_OFF);
    sample_setup(p, sm, smp, shf);
    f32x4 sr[4]; f32x4 sya = {0.f, 0.f, 0.f, 0.f};
    issue(0);
    __syncthreads();
    for (int step = 0; step < NSTEP; ++step) {
        const LAS float* dtS = dtA + step * 64; const LAS float* lcS = lcA + step * 64;
        const float lc_last = lcS[63];
#pragma unroll
        for (int i = 0; i < 2; ++i) { const int row = brow + 32 * i;
            const float wts = __expf(lc_last - lcS[row]) * dtS[row];
            u32x4 w;
#pragma unroll
            for (int e = 0; e < 4; ++e) w[e] = pack2(lo16(rb[i][e]) * wts, hi16(rb[i][e]) * wts);
            *(LAS u32x4*)(Bs + row * 136 + 8 * bch) = rb[i]; *(LAS u32x4*)(Bw + row * 136 + 8 * bch) = w; *(LAS u32x4*)(Cs + row * 136 + 8 * bch) = rc[i]; }
        if (tid < 256) *(LAS u32x4*)(Xs + xrow * 40 + 8 * x8) = rx;
        __syncthreads();
        if (step == 16 || step == 24) sample_finalize(p, sm, smp, shf, step == 16 ? 0 : 1);
        float zc[4];
#pragma unroll
        for (int r = 0; r < 4; ++r) zc[r] = bf2f(rz[r]);
        if (step + 1 < NSTEP) issue(step + 1);
        if (step < NSLICE) sample_issue(p, smp, shf, step, sr);
        const int ib = wid >> 1, pb = wid & 1;
        f32x4 acc3 = {0.f, 0.f, 0.f, 0.f};
        {
            f32x4 sc[2]; sc[0] = (f32x4){0.f, 0.f, 0.f, 0.f}; sc[1] = sc[0];
            const int jb0 = 2 * pb;
            mma16x3<128>(sc[0], sc[1], acc3, Cs + ib * 16 * 136, Bs + jb0 * 16 * 136, Bs + (jb0 + 1) * 16 * 136, Hs + pb * 16 * 136, 136, fr, fq);
#pragma unroll
            for (int tt = 0; tt < 2; ++tt) {
                const int j = (jb0 + tt) * 16 + fr; const float lcj = lcS[j], dtj = dtS[j];
#pragma unroll
                for (int r = 0; r < 4; ++r) { const int i = ib * 16 + fq * 4 + r;
                    const float val = (j <= i) ? sc[tt][r] * __expf(lcS[i] - lcj) * dtj : 0.f;
                    Ps[i * 72 + j] = f2bf(val); }
            }
        }
        __syncthreads();
        f32x4 acc2 = {0.f, 0.f, 0.f, 0.f};
#pragma unroll
        for (int k0 = 0; k0 < 64; k0 += 32) acc2 = MFMA16(ld_row(Ps + ib * 16 * 72, 72, k0, fr, fq), ld_tr(Xs + pb * 16, 40, k0, fr, fq), acc2);
        if (step > 0) {
#pragma unroll
            for (int r = 0; r < 4; ++r) { const int i = ib * 16 + fq * 4 + r, pl = pb * 16 + fr;
                const float xv = bf2f(Xs[i * 40 + pl]);
                const float yv = acc2[r] + __expf(lcS[i]) * acc3[r] + dsk * xv;
                const unsigned grow = (unsigned)step_row(b, step, i);
                const float z = zc[r];
                Y[grow * DM + h * 64 + ph * 32 + pl] = f2bf(yv * silu_f(z)); }
        }
        const float dec = __expf(lc_last);
#pragma unroll
        for (int tt = 0; tt < 2; ++tt) {
            hacc[tt] *= dec;
#pragma unroll
            for (int k0 = 0; k0 < 64; k0 += 32) hacc[tt] = MFMA16(ld_tr(Xs + tt * 16, 40, k0, fr, fq), ld_tr(Bw + wid * 16, 136, k0, fr, fq), hacc[tt]);
        }
        if (step < NSLICE) sample_process(p, sm, smp, shf, step, sr, sya);
        __syncthreads();
#pragma unroll
        for (int tt = 0; tt < 2; ++tt)
#pragma unroll
            for (int r = 0; r < 4; ++r) Hs[(tt * 16 + fq * 4 + r) * 136 + wid * 16 + fr] = f2bf(hacc[tt][r]);
    }
    float* o = p.out + O_PSSM + (size_t)(b * 16 + h) * 64 * 128;
#pragma unroll
    for (int tt = 0; tt < 2; ++tt)
#pragma unroll
        for (int r = 0; r < 4; ++r) o[(size_t)(ph * 32 + tt * 16 + fq * 4 + r) * 128 + wid * 16 + fr] = hacc[tt][r];
}

__device__ void phase_mixers(const Params& p, LAS unsigned char* lds) {
    for (int t = blockIdx.x; t < 128; t += gridDim.x) {
        const int x = t & 7, k = t >> 3, task = (x * 2 + (k >> 3)) * 8 + (k & 7);
        ret_task(p, lds, task >> 5, (task >> 3) & 3, task & 7, t >> 1, t & 1);
        __syncthreads();
    }
    for (int t = blockIdx.x; t < 256; t += gridDim.x) {
        if (t >= 128) { const int tt = t - 128, u = (tt & 7) * 16 + (tt >> 3); ssd_task(p, lds, u >> 5, (u >> 1) & 15, u & 1, t >> 1, t & 1); __syncthreads(); }
    }
}

__device__ void aux_gemm(const bf16_t* __restrict__ A, int lda, const bf16_t* __restrict__ Bt, int K, float* __restrict__ C0, float* __restrict__ C1) {
    const int tid = threadIdx.x, wid = tid >> 6, lane = tid & 63, fr = lane & 15, fq = lane >> 4;
    for (int task = blockIdx.x; task < 256; task += gridDim.x) {
        const int cb = task & 127, kh = task >> 7, Kh = K >> 1;
        const bf16_t* ap = A + (size_t)(16 * wid + fr) * lda + kh * Kh + 8 * fq;
        const bf16_t* bp = Bt + (size_t)(cb * 16 + fr) * K + kh * Kh + 8 * fq;
        f32x4 acc0 = {0.f, 0.f, 0.f, 0.f}, acc1 = acc0;
#pragma unroll 4
        for (int k = 0; k < Kh; k += 64) {
            const bf16x8 a0 = *(const bf16x8*)(ap + k), b0 = *(const bf16x8*)(bp + k);
            const bf16x8 a1 = *(const bf16x8*)(ap + k + 32), b1 = *(const bf16x8*)(bp + k + 32);
            acc0 = MFMA16(a0, b0, acc0); acc1 = MFMA16(a1, b1, acc1);
        }
        float* C = kh ? C1 : C0;
#pragma unroll
        for (int r = 0; r < 4; ++r) C[(size_t)(16 * wid + fq * 4 + r) * DM + cb * 16 + fr] = acc0[r] + acc1[r];
    }
}

__device__ __forceinline__ void wave_sum8(float (&s)[8]) {
    const int lane = threadIdx.x & 63; const bool b5 = (lane & 32) != 0, b4 = (lane & 16) != 0, b3 = (lane & 8) != 0;
    float a[4], c[2];
#pragma unroll
    for (int k = 0; k < 4; ++k) a[k] = (b5 ? s[k + 4] : s[k]) + __shfl_xor(b5 ? s[k] : s[k + 4], 32);
#pragma unroll
    for (int k = 0; k < 2; ++k) c[k] = (b4 ? a[k + 2] : a[k]) + __shfl_xor(b4 ? a[k] : a[k + 2], 16);
    float d = (b3 ? c[1] : c[0]) + __shfl_xor(b3 ? c[0] : c[1], 8);
    d += __shfl_xor(d, 4); d += __shfl_xor(d, 2); d += __shfl_xor(d, 1);
#pragma unroll
    for (int q = 0; q < 8; ++q) s[q] = __int_as_float(__builtin_amdgcn_readlane(__float_as_int(d), q * 8));
}
__device__ void phase_normmix(const Params& p) {
    const int wid = threadIdx.x >> 6, lane = threadIdx.x & 63, nw = gridDim.x * 8;
    const bf16_t* Y = (const bf16_t*)(p.ws + WS_TMP);
    const bf16_t* proj = (const bf16_t*)(p.ws + WS_PROJ);
    bf16_t* MIX = (bf16_t*)(p.ws + WS_ABUF);
    for (int row0 = blockIdx.x * 8 + wid; row0 < MOUT; row0 += 2 * nw) {
        float4 v[2][8]; u32x2 gg[2][4];
#pragma unroll
        for (int u = 0; u < 2; ++u) { const int row = row0 + u * nw;
            if (row < MOUT) { const bf16_t* y = Y + (size_t)row * DM;
#pragma unroll
                for (int q = 0; q < 8; ++q) v[u][q] = ld4bf(y + q * 256 + lane * 4);
#pragma unroll
                for (int q = 0; q < 4; ++q) gg[u][q] = *(const u32x2*)(proj + (size_t)row * PROJP + OG + q * 256 + lane * 4); } }
#pragma unroll
        for (int u = 0; u < 2; ++u) { const int row = row0 + u * nw;
            if (row < MOUT) {
                float ss[8];
#pragma unroll
                for (int q = 0; q < 8; ++q) ss[q] = v[u][q].x * v[u][q].x + v[u][q].y * v[u][q].y + v[u][q].z * v[u][q].z + v[u][q].w * v[u][q].w;
                wave_sum8(ss);
                float rs[8];
                rs[0] = rs[1] = rsqrtf((ss[0] + ss[1]) * (1.0f / 512.0f) + EPS);
                rs[2] = rs[3] = rsqrtf((ss[2] + ss[3]) * (1.0f / 512.0f) + EPS);
#pragma unroll
                for (int q = 4; q < 8; ++q) rs[q] = rsqrtf(ss[q] * (1.0f / 256.0f) + EPS);
#pragma unroll
                for (int q = 0; q < 8; ++q) {
                    const int col = q * 256 + lane * 4;
                    float4 g; float4 o; const float4 w4 = v[u][q];
                    if (q < 4) { g = *(const float4*)(p.ssm_norm_g + col); o.x = w4.x * rs[q] * g.x; o.y = w4.y * rs[q] * g.y; o.z = w4.z * rs[q] * g.z; o.w = w4.w * rs[q] * g.w; }
                    else { g = *(const float4*)(p.ret_norm_g + col - 1024);
                        const u32x2 gq = gg[u][q - 4];
                        o.x = w4.x * rs[q] * g.x * silu_f(lo16(gq.x)); o.y = w4.y * rs[q] * g.y * silu_f(hi16(gq.x));
                        o.z = w4.z * rs[q] * g.z * silu_f(lo16(gq.y)); o.w = w4.w * rs[q] * g.w * silu_f(hi16(gq.y)); }
                    u32x2 w; w.x = pack2(o.x, o.y); w.y = pack2(o.z, o.w);
                    *(u32x2*)(MIX + (size_t)row * DM + col) = w;
                }
            } }
    }
}

__device__ void phase_mid(const Params& p) {
    const int wid = threadIdx.x >> 6, lane = threadIdx.x & 63, nw = gridDim.x * 8;
    const bf16_t* T = (const bf16_t*)(p.ws + WS_TMP);
    bf16_t* H1 = (bf16_t*)(p.ws + WS_H1);
    bf16_t* F = (bf16_t*)(p.ws + WS_ABUF);
    float4 g1[8], g2[8];
#pragma unroll
    for (int q = 0; q < 8; ++q) { g1[q] = *(const float4*)(p.post_mix_g + q * 256 + lane * 4); g2[q] = *(const float4*)(p.pre_ffn_g + q * 256 + lane * 4); }
    for (int row = blockIdx.x * 8 + wid; row < MOUT; row += nw) {
        const bf16_t* t = T + (size_t)row * DM; const float* x = src_row(p, row);
        const float* t2 = (const float*)(p.ws + WS_AUX2) + (size_t)(row - SROW0) * DM;
        float4 v[8], hx[8]; float ss = 0.f;
#pragma unroll
        for (int q = 0; q < 8; ++q) { hx[q] = *(const float4*)(x + q * 256 + lane * 4);
            if (row >= SROW0) { const float4 a = *(const float4*)(t2 + q * 256 + lane * 4), w = *(const float4*)(t2 + (size_t)DECB * DM + q * 256 + lane * 4);
                v[q] = make_float4(a.x + w.x, a.y + w.y, a.z + w.z, a.w + w.w); }
            else v[q] = ld4bf(t + q * 256 + lane * 4); }
#pragma unroll
        for (int q = 0; q < 8; ++q) ss += v[q].x * v[q].x + v[q].y * v[q].y + v[q].z * v[q].z + v[q].w * v[q].w;
        ss = wave_sum(ss);
        const float rs = rsqrtf(ss * (1.0f / DM) + EPS);
        float ss2 = 0.f;
#pragma unroll
        for (int q = 0; q < 8; ++q) { const int col = q * 256 + lane * 4; const float4 g = g1[q]; const float4 h = hx[q];
            float4& w = v[q];
            w.x = h.x + w.x * rs * g.x; w.y = h.y + w.y * rs * g.y; w.z = h.z + w.z * rs * g.z; w.w = h.w + w.w * rs * g.w;
            { u32x2 hw; hw.x = pack2(w.x, w.y); hw.y = pack2(w.z, w.w); *(u32x2*)(H1 + (size_t)row * DM + col) = hw; }
            ss2 += w.x * w.x + w.y * w.y + w.z * w.z + w.w * w.w; }
        ss2 = wave_sum(ss2);
        const float rs2 = rsqrtf(ss2 * (1.0f / DM) + EPS);
#pragma unroll
        for (int q = 0; q < 8; ++q) { const int col = q * 256 + lane * 4; const float4 g = g2[q];
            u32x2 w; w.x = pack2(v[q].x * rs2 * g.x, v[q].y * rs2 * g.y); w.y = pack2(v[q].z * rs2 * g.z, v[q].w * rs2 * g.w);
            *(u32x2*)(F + (size_t)row * DM + col) = w; }
    }
}

__device__ void phase_final(const Params& p) {
    const int wid = threadIdx.x >> 6, lane = threadIdx.x & 63, nw = gridDim.x * 8;
    const bf16_t* T = (const bf16_t*)(p.ws + WS_TMP);
    const bf16_t* H1 = (const bf16_t*)(p.ws + WS_H1);
    float4 g1[8];
#pragma unroll
    for (int q = 0; q < 8; ++q) g1[q] = *(const float4*)(p.post_ffn_g + q * 256 + lane * 4);
    for (int row = blockIdx.x * 8 + wid; row < MOUT; row += nw) {
        float* o = row < MMAIN ? p.out + O_YP + (size_t)row * DM : p.out + O_YS + (size_t)(row - SROW0) * DM;
        const bf16_t* t = T + (size_t)row * DM; const bf16_t* h = H1 + (size_t)row * DM;
        const float* t2 = (const float*)(p.ws + WS_AUX2) + (size_t)(row - SROW0) * DM;
        float4 v[8], hx[8]; float ss = 0.f;
#pragma unroll
        for (int q = 0; q < 8; ++q) { hx[q] = ld4bf(h + q * 256 + lane * 4);
            if (row >= SROW0) { const float4 a = *(const float4*)(t2 + q * 256 + lane * 4), w = *(const float4*)(t2 + (size_t)DECB * DM + q * 256 + lane * 4);
                v[q] = make_float4(a.x + w.x, a.y + w.y, a.z + w.z, a.w + w.w); }
            else v[q] = ld4bf(t + q * 256 + lane * 4); }
#pragma unroll
        for (int q = 0; q < 8; ++q) ss += v[q].x * v[q].x + v[q].y * v[q].y + v[q].z * v[q].z + v[q].w * v[q].w;
        ss = wave_sum(ss);
        const float rs = rsqrtf(ss * (1.0f / DM) + EPS);
#pragma unroll
        for (int q = 0; q < 8; ++q) { const int col = q * 256 + lane * 4; const float4 g = g1[q]; const float4 hh = hx[q];
            float4 r; r.x = hh.x + v[q].x * rs * g.x; r.y = hh.y + v[q].y * rs * g.y; r.z = hh.z + v[q].z * rs * g.z; r.w = hh.w + v[q].w * rs * g.w;
            *(float4*)(o + col) = r; }
    }
}

__global__ void __launch_bounds__(512, 2) hymba_mega(Params p) {
    extern __shared__ __attribute__((aligned(16))) unsigned char shm[];
    LAS unsigned char* lds = (LAS unsigned char*)shm;
    cg::grid_group grid = cg::this_grid();
    volatile LAS unsigned* xst = (volatile LAS unsigned*)(lds + LDS_ST);
    if (threadIdx.x < 4) xst[threadIdx.x] = 0u;
    __syncthreads();
    const XcdBarrier xb = xcd_barrier_post((unsigned*)(p.ws + WS_BAR), xst);
#define PHASE(i) if (p.ph_lo <= (i) && (i) < p.ph_hi)
#define SEAM(i) do { if (p.ph_lo <= (i) && (i) + 1 < p.ph_hi) { if (p.coop == 1) xcd_barrier(xb); else if (p.coop == 2) grid.sync(); } } while (0)
    PHASE(0) phase_prep(p, lds);
    SEAM(0);
    PHASE(1) {
        pg8::Gemm g{(const bf16_t*)(p.ws + WS_ABUF), (const bf16_t*)(p.ws + WS_WIN), MPAD, PROJP, DM};
        pg8::StaticOrder S; S.init(MPAD, PROJP, gridDim.x, blockIdx.x);
        pg8::EpiBf16 E{(bf16_t*)(p.ws + WS_PROJ), PROJP};
        pg8::gemm_phase(lds, g, S, E);
        {
            const int G = gridDim.x, r = S.nwg % G, c = blockIdx.x;
            __syncthreads();
            if (r == 0) weights_pass(p, lds, WT0, WT3, c, G);
            else if (c >= r) weights_pass(p, lds, WT0, WT3, c - r, G - r);
        }
    }
    SEAM(1);
    PHASE(2) phase_convrope(p);
    SEAM(2);
    PHASE(3) phase_mixers(p, lds);
    SEAM(3);
    PHASE(4) phase_normmix(p);
    SEAM(4);
    PHASE(5) {
        pg8::Gemm g{(const bf16_t*)(p.ws + WS_ABUF), (const bf16_t*)(p.ws + WS_WOUT), MMAIN, DM, DM};
        pg8::StaticOrder S; S.init(MMAIN, DM, gridDim.x, blockIdx.x);
        pg8::EpiBf16 E{(bf16_t*)(p.ws + WS_TMP), DM};
        pg8::gemm_phase(lds, g, S, E);
        aux_gemm((const bf16_t*)(p.ws + WS_ABUF) + (size_t)SROW0 * DM, DM, (const bf16_t*)(p.ws + WS_WOUT), DM, (float*)(p.ws + WS_AUX2), (float*)(p.ws + WS_AUX2) + (size_t)DECB * DM);
    }
    SEAM(5);
    PHASE(6) phase_mid(p);
    SEAM(6);
    PHASE(7) {
        pg8::Gemm g{(const bf16_t*)(p.ws + WS_ABUF), (const bf16_t*)(p.ws + WS_WGU), MPAD, 2 * DFF, DM};
        pg8::StaticOrder S; S.init(MPAD, 2 * DFF, gridDim.x, blockIdx.x);
        pg8::EpiSwiGLU E{(bf16_t*)(p.ws + WS_PROJ), DFF};
        pg8::gemm_phase(lds, g, S, E);
        {
            const int G = gridDim.x, r = S.nwg % G, c = blockIdx.x;
            __syncthreads();
            if (r == 0) weights_pass(p, lds, WT3, WT4, c, G);
            else if (c >= r) weights_pass(p, lds, WT3, WT4, c - r, G - r);
        }
    }
    SEAM(7);
    PHASE(8) {
        pg8::Gemm g{(const bf16_t*)(p.ws + WS_PROJ), (const bf16_t*)(p.ws + WS_WDN), MMAIN, DM, DFF};
        pg8::StaticOrder S; S.init(MMAIN, DM, gridDim.x, blockIdx.x);
        pg8::EpiBf16 E{(bf16_t*)(p.ws + WS_TMP), DM};
        pg8::gemm_phase(lds, g, S, E);
        aux_gemm((const bf16_t*)(p.ws + WS_PROJ) + (size_t)SROW0 * DFF, DFF, (const bf16_t*)(p.ws + WS_WDN), DFF, (float*)(p.ws + WS_AUX2), (float*)(p.ws + WS_AUX2) + (size_t)DECB * DM);
    }
    SEAM(8);
    PHASE(9) phase_final(p);
#undef PHASE
#undef SEAM
}

extern "C" void kernel_launch(void* const* d_in, const int* in_sizes, int n_in, void* d_out, int out_size, void* d_ws, size_t ws_size, hipStream_t stream) {
    static int grid = 0;
    if (grid == 0) {
        if (n_in != 22 || (size_t)out_size != O_END || ws_size < WS_END) { fprintf(stderr, "kernel_launch: unexpected shapes (n_in %d out %d ws %zu need %zu)\n", n_in, out_size, ws_size, (size_t)WS_END); grid = -1; return; }
        int dev = 0, cus = 0, per_cu = 0;
        (void)hipGetDevice(&dev);
        (void)hipDeviceGetAttribute(&cus, hipDeviceAttributeMultiprocessorCount, dev);
        if (hipFuncSetAttribute((const void*)hymba_mega, hipFuncAttributeMaxDynamicSharedMemorySize, LDS_BYTES) != hipSuccess) { fprintf(stderr, "kernel_launch: hipFuncSetAttribute failed\n"); grid = -1; return; }
        if (hipOccupancyMaxActiveBlocksPerMultiprocessor(&per_cu, (const void*)hymba_mega, 512, LDS_BYTES) != hipSuccess || per_cu < 1) { fprintf(stderr, "kernel_launch: occupancy query gave %d\n", per_cu); per_cu = 1; }
        (void)hipGetLastError();
        grid = cus * 1;
        if (grid <= 0) grid = 256;
    }
    if (grid < 0) return;
    Params p;
    memset(&p, 0, sizeof(p));
    const float** f = (const float**)&p;
    for (int i = 0; i < 22; ++i) f[i] = (const float*)d_in[i];
    p.out = (float*)d_out; p.ws = (unsigned char*)d_ws;
    p.lg0 = (float)log1p(-exp2(-5.0)); p.lg1 = (float)log1p(-exp2(-6.0)); p.lg2 = (float)log1p(-exp2(-7.0)); p.lg3 = (float)log1p(-exp2(-8.0));
    if (hipMemsetAsync((char*)d_ws + WS_BAR, 0, 16384, stream) != hipSuccess) { fprintf(stderr, "kernel_launch: memset of barrier words failed\n"); return; }
#if COOP_LAUNCH
    p.ph_lo = 0; p.ph_hi = NPHASE; p.coop = 1;
    void* args[] = {&p};
    hipError_t e = hipLaunchCooperativeKernel((const void*)hymba_mega, dim3(grid), dim3(512), args, LDS_BYTES, stream);
    if (e != hipSuccess) fprintf(stderr, "cooperative launch failed: %s (grid %d)\n", hipGetErrorString(e), grid);
#else
    for (int ph = 0; ph < NPHASE; ++ph) {
        p.ph_lo = ph; p.ph_hi = ph + 1; p.coop = 0;
        hipLaunchKernelGGL(hymba_mega, dim3(grid), dim3(512), LDS_BYTES, stream, p);
    }
#endif
}
```

```cpp
#include <hip/hip_runtime.h>
#include <hip/hip_cooperative_groups.h>
#include <cstdio>
#include <cmath>
#include <cstring>
namespace cg = cooperative_groups;

#ifndef COOP_LAUNCH
#define COOP_LAUNCH 1
#endif

#define LAS __attribute__((address_space(3)))
typedef unsigned short bf16_t;
typedef short bf16x8 __attribute__((ext_vector_type(8)));
typedef float f32x4 __attribute__((ext_vector_type(4)));
typedef unsigned u32x4 __attribute__((ext_vector_type(4)));
typedef unsigned u32x2 __attribute__((ext_vector_type(2)));

constexpr int DM = 2048, NBATCH = 4, SEQL = 2048, NMETA = 16, LP = SEQL + NMETA, DECB = 128;
constexpr int MMAIN = NBATCH * SEQL;
constexpr int SROW0 = MMAIN;
constexpr int MROW0 = SROW0 + DECB;
constexpr int MTOT = MROW0 + NMETA;
constexpr int MOUT = MROW0;
constexpr int MPAD = 8448;
constexpr int CONVD = 1536, DFF = 5632, PROJD = 6672, PROJP = 6912;
constexpr int OZ = 0, OX = 1024, OB = 2048, OC = 2304, ODT = 2560, OQ = 2576, OKK = 3600, OV = 4624, OG = 5648;
constexpr int NSTEP = 33;
constexpr int TABROWS = LP + 1;
constexpr float EPS = 1e-6f;

constexpr size_t WS_WIN = 0;
constexpr size_t WS_WOUT = WS_WIN + (size_t)PROJP * DM * 2;
constexpr size_t WS_WGU = WS_WOUT + (size_t)DM * DM * 2;
constexpr size_t WS_WDN = WS_WGU + (size_t)2 * DFF * DM * 2;
constexpr size_t WS_ABUF = WS_WDN + (size_t)DM * DFF * 2;
constexpr size_t WS_PROJ = WS_ABUF + (size_t)MPAD * DM * 2;
constexpr size_t WS_TMP = WS_PROJ + (size_t)MPAD * PROJP * 2;
constexpr size_t WS_H1 = WS_TMP + (size_t)MPAD * DM * 4;
constexpr size_t WS_TAB = WS_H1 + (size_t)MPAD * DM * 4;
constexpr size_t WS_XC = WS_TAB + (size_t)TABROWS * 256 * 4;
constexpr size_t WS_AUX2 = WS_XC + (size_t)MPAD * CONVD * 2;
constexpr size_t WS_BAR = WS_AUX2 + (size_t)2 * DECB * DM * 4;
constexpr size_t WS_END = WS_BAR + 16384;

constexpr size_t O_YP = 0;
constexpr size_t O_YS = O_YP + (size_t)NBATCH * SEQL * DM;
constexpr size_t O_PCONV = O_YS + (size_t)DECB * DM;
constexpr size_t O_PSSM = O_PCONV + (size_t)NBATCH * 3 * CONVD;
constexpr size_t O_PRET = O_PSSM + (size_t)NBATCH * 16 * 64 * 128;
constexpr size_t O_SCONV = O_PRET + (size_t)NBATCH * 4 * 256 * 256;
constexpr size_t O_SSSM = O_SCONV + (size_t)DECB * 3 * CONVD;
constexpr size_t O_SRET = O_SSSM + (size_t)DECB * 16 * 64 * 128;
constexpr size_t O_END = O_SRET + (size_t)DECB * 4 * 256 * 256;

constexpr int LDS_ST = 135168;
constexpr int LDS_BYTES = LDS_ST + 16;
constexpr int NPHASE = 10;

struct Params {
    const float *x_prompt, *x_sample, *state_conv, *state_ssm, *state_ret, *meta, *pre_mix_g, *post_mix_g, *pre_ffn_g, *post_ffn_g,
        *w_in, *conv_w, *conv_b, *dt_bias, *a_log, *d_skip, *ssm_norm_g, *ret_norm_g, *w_out, *w_gate, *w_up, *w_down;
    float* out;
    unsigned char* ws;
    float lg0, lg1, lg2, lg3;
    int ph_lo, ph_hi, coop, pad;
};

__device__ __forceinline__ float bf2f(bf16_t b) { return __uint_as_float(((unsigned)b) << 16); }
typedef __bf16 nbf16x2 __attribute__((ext_vector_type(2)));
typedef float f32x2n __attribute__((ext_vector_type(2)));
__device__ __forceinline__ bf16_t f2bf(float f) { const __bf16 h = (__bf16)f; return __builtin_bit_cast(unsigned short, h); }
__device__ __forceinline__ unsigned pack2(float a, float b) { const f32x2n v = {a, b}; const nbf16x2 h = __builtin_convertvector(v, nbf16x2); return __builtin_bit_cast(unsigned, h); }
__device__ __forceinline__ float lo16(unsigned u) { return __uint_as_float(u << 16); }
__device__ __forceinline__ float hi16(unsigned u) { return __uint_as_float(u & 0xffff0000u); }
__device__ __forceinline__ float4 ld4bf(const bf16_t* p) { const u32x2 u = *(const u32x2*)p; return make_float4(lo16(u.x), hi16(u.x), lo16(u.y), hi16(u.y)); }
__device__ __forceinline__ float silu_f(float x) { return x * __builtin_amdgcn_rcpf(1.0f + __expf(-x)); }
__device__ __forceinline__ float softplus_f(float x) { return fmaxf(x, 0.0f) + log1pf(__expf(-fabsf(x))); }
__device__ __forceinline__ float wave_sum(float v) {
#pragma unroll
    for (int o = 32; o >= 1; o >>= 1) v += __shfl_xor(v, o);
    return v;
}
__device__ __forceinline__ void lds_barrier() { asm volatile("s_waitcnt lgkmcnt(0)\n\ts_barrier" ::: "memory"); }
__device__ __forceinline__ unsigned cvt_pk_bf16(float lo, float hi) { unsigned r; asm volatile("v_cvt_pk_bf16_f32 %0, %1, %2" : "=v"(r) : "v"(lo), "v"(hi)); return r; }

__device__ __forceinline__ const float* src_row(const Params& p, int row) {
    if (row < MMAIN) return p.x_prompt + (size_t)row * DM;
    if (row < MROW0) return p.x_sample + (size_t)(row - SROW0) * DM;
    return p.meta + (size_t)(row - MROW0) * DM;
}
__device__ __forceinline__ int prow(int b, int t) { return t < NMETA ? MROW0 + t : b * SEQL + t - NMETA; }

template <int K>
__device__ __forceinline__ void mma16(f32x4& acc, const LAS bf16_t* A, int lda, const LAS bf16_t* Bt, int ldb, int fr, int fq) {
    const LAS bf16_t* ap = A + fr * lda + fq * 8; const LAS bf16_t* bp = Bt + fr * ldb + fq * 8;
#pragma unroll 1
    for (int k0 = 0; k0 < K; k0 += 64) {
#pragma unroll
        for (int k1 = 0; k1 < 64; k1 += 32) {
            const bf16x8 a = *(const LAS bf16x8*)(ap + k0 + k1);
            const bf16x8 b = *(const LAS bf16x8*)(bp + k0 + k1);
            acc = __builtin_amdgcn_mfma_f32_16x16x32_bf16(a, b, acc, 0, 0, 0);
        }
    }
}

template <int K>
__device__ __forceinline__ void mma16x3(f32x4& c0, f32x4& c1, f32x4& c2, const LAS bf16_t* A, const LAS bf16_t* B0, const LAS bf16_t* B1, const LAS bf16_t* B2, int ld, int fr, int fq) {
    const int off = fr * ld + fq * 8;
    const LAS bf16_t* ap = A + off; const LAS bf16_t* p0 = B0 + off; const LAS bf16_t* p1 = B1 + off; const LAS bf16_t* p2 = B2 + off;
#pragma unroll 1
    for (int k0 = 0; k0 < K; k0 += 128) {
#pragma unroll
        for (int k1 = 0; k1 < 128; k1 += 32) {
            const bf16x8 a = *(const LAS bf16x8*)(ap + k0 + k1);
            const bf16x8 x0 = *(const LAS bf16x8*)(p0 + k0 + k1), x1 = *(const LAS bf16x8*)(p1 + k0 + k1), x2 = *(const LAS bf16x8*)(p2 + k0 + k1);
            c0 = __builtin_amdgcn_mfma_f32_16x16x32_bf16(a, x0, c0, 0, 0, 0);
            c1 = __builtin_amdgcn_mfma_f32_16x16x32_bf16(a, x1, c1, 0, 0, 0);
            c2 = __builtin_amdgcn_mfma_f32_16x16x32_bf16(a, x2, c2, 0, 0, 0);
        }
    }
}
typedef short s16x4 __attribute__((ext_vector_type(4)));
__device__ __forceinline__ bf16x8 ld_row(const LAS bf16_t* M, int ld, int k0, int fr, int fq) { return *(const LAS bf16x8*)(M + fr * ld + k0 + fq * 8); }
__device__ __forceinline__ bf16x8 ld_tr(const LAS bf16_t* M, int ld, int k0, int fr, int fq) {
    const LAS bf16_t* a = M + (k0 + 8 * fq + (fr >> 2)) * ld + 4 * (fr & 3);
    const s16x4 lo = __builtin_amdgcn_ds_read_tr16_b64_v4i16((LAS s16x4*)a);
    const s16x4 hi = __builtin_amdgcn_ds_read_tr16_b64_v4i16((LAS s16x4*)(a + 4 * ld));
    return (bf16x8){lo[0], lo[1], lo[2], lo[3], hi[0], hi[1], hi[2], hi[3]};
}
#define MFMA16(a, b, c) __builtin_amdgcn_mfma_f32_16x16x32_bf16(a, b, c, 0, 0, 0)

#define XB_TMO      128
#define XB_XCNT(j)  (256  + 64 * (j))
#define XB_XSUB(j)  (1280 + 64 * (j))
#define XB_XGEN(j)  (2304 + 64 * (j))
#define XB_TOP      3328
#define XB_TOPGEN   3392
#define XCD_BAR_WORDS 3456
#define XB_SPIN_CAP (1u << 18)
__device__ __forceinline__ unsigned xb_ld(unsigned* p)              { return __hip_atomic_load(p, __ATOMIC_RELAXED, __HIP_MEMORY_SCOPE_AGENT); }
__device__ __forceinline__ unsigned xb_add(unsigned* p, unsigned v) { return __hip_atomic_fetch_add(p, v, __ATOMIC_RELAXED, __HIP_MEMORY_SCOPE_AGENT); }
__device__ __forceinline__ unsigned xb_xcc_id() { return (unsigned)__builtin_amdgcn_s_getreg((3 << 11) | 20) & 0xFu; }
#define XB_SPIN(cond, bar) do { unsigned _sp = 0; while (cond) { __builtin_amdgcn_s_sleep(1); \
    if ((++_sp & 255u) == 0u) { if (xb_ld(&(bar)[XB_TMO])) break; if (_sp > XB_SPIN_CAP) { atomicAdd(&(bar)[XB_TMO], 1u); break; } } } } while (0)
struct XcdBarrier { unsigned* bar; unsigned x; volatile LAS unsigned* st; };
__device__ __forceinline__ XcdBarrier xcd_barrier_post(unsigned* bar, volatile LAS unsigned* st) {
    XcdBarrier b; b.bar = bar; b.x = xb_xcc_id(); b.st = st;
    if (threadIdx.x == 0) (void)xb_add(&bar[XB_XCNT(b.x)], 1u);
    return b;
}
__device__ __forceinline__ void xcd_barrier_complete(unsigned* bar, unsigned x, unsigned& nloc, unsigned& nx) {
    const unsigned G = gridDim.x * gridDim.y * gridDim.z;
    unsigned sum, cnt, mine, sp = 0u;
    for (;;) {
        sum = 0u; cnt = 0u; mine = 0u;
#pragma unroll
        for (unsigned j = 0; j < 16; ++j) { const unsigned c = xb_ld(&bar[XB_XCNT(j)]); sum += c; cnt += (c > 0u) ? 1u : 0u; mine = (j == x) ? c : mine; }
        if (sum == G) break;
        __builtin_amdgcn_s_sleep(1);
        if ((++sp & 255u) == 0u) { if (xb_ld(&bar[XB_TMO])) break; if (sp > XB_SPIN_CAP) { atomicAdd(&bar[XB_TMO], 1u); break; } }
    }
    nloc = mine > 0u ? mine : 1u; nx = cnt > 0u ? cnt : 1u;
}
__device__ __forceinline__ void xcd_barrier(const XcdBarrier& b) {
    asm volatile("s_waitcnt vmcnt(0)" ::: "memory");
    __syncthreads();
    if (threadIdx.x == 0) {
        unsigned* bar = b.bar;
        __builtin_amdgcn_s_waitcnt(0);
        unsigned nloc = b.st[0], nx = b.st[1];
        if (nloc == 0u) { xcd_barrier_complete(bar, b.x, nloc, nx); b.st[0] = nloc; b.st[1] = nx; }
        const unsigned old = xb_add(&bar[XB_XSUB(b.x)], 1u);
        const unsigned gen = old / nloc;
        if (old + 1u == (gen + 1u) * nloc) {
            __builtin_amdgcn_fence(__ATOMIC_RELEASE, "agent");
            asm volatile("s_waitcnt vmcnt(0)" ::: "memory");
            const unsigned og = xb_add(&bar[XB_TOP], 1u);
            const unsigned tg = og / nx;
            if (og + 1u == (tg + 1u) * nx) xb_add(&bar[XB_TOPGEN], 1u);
            else XB_SPIN(xb_ld(&bar[XB_TOPGEN]) == tg, bar);
            __builtin_amdgcn_fence(__ATOMIC_ACQUIRE, "agent");
            xb_add(&bar[XB_XGEN(b.x)], 1u);
            asm volatile("s_waitcnt vmcnt(0)" ::: "memory");
        } else {
            XB_SPIN(xb_ld(&bar[XB_XGEN(b.x)]) == gen, bar);
            __builtin_amdgcn_fence(__ATOMIC_ACQUIRE, "agent");
            asm volatile("s_waitcnt vmcnt(0)" ::: "memory");
        }
    }
    __syncthreads();
}

namespace pg8 {
constexpr int BM = 256, BK = 64, HALF = 128, HTB = HALF * BK * 2, STAGE_BYTES = 8 * HTB, NXCD = 8, WGM = 8;
__host__ __device__ __forceinline__ int lds_byte(int r, int c) { const int st = (r >> 4) * 2 + (c >> 5), rr = r & 15, cc = c & 31, ob = rr * 64 + cc * 2; return st * 1024 + (ob ^ (((ob >> 9) & 1) << 5)); }
__host__ __device__ __forceinline__ void stage_rc(int b, int& R, int& C) { const int st = b / 1024, sb = b % 1024, swz = sb ^ (((sb >> 9) & 1) << 5); R = (st >> 1) * 16 + swz / 64; C = (st & 1) * 32 + (swz % 64) / 2; }
__host__ __device__ __forceinline__ int perm32(int rho) { const int n = rho >> 4, i = rho & 15; return 8 * (i >> 2) + 4 * n + (i & 3); }
struct Unit { int pm, pn; };
struct Gemm { const bf16_t* A; const bf16_t* Bt; int M, N, K; };
struct StaticOrder {
    int nM, nN, nwg, G, c;
    __host__ __device__ void init(int M, int N, int G_, int c_) { nM = M / BM; nN = N / BM; nwg = nM * nN; G = G_; c = c_; }
    __host__ __device__ bool next(int i, Unit& u) const {
        const long L = (long)i * G + c; if (L >= nwg) return false;
        int wgid = (int)L; { const int q = nwg / NXCD, r = nwg % NXCD, xcd = wgid % NXCD, off = wgid / NXCD; wgid = (xcd < r ? xcd * (q + 1) : r * (q + 1) + (xcd - r) * q) + off; }
        const int nig = WGM * nN, gid = wgid / nig, fm = gid * WGM, gsz = (nM - fm) < WGM ? (nM - fm) : WGM;
        u.pm = fm + ((wgid % nig) % gsz); u.pn = (wgid % nig) / gsz; return true;
    }
};

struct EpiF32 {
    static constexpr bool PERM = false;
    float* C; int ldc;
    __device__ __forceinline__ void operator()(const f32x4 (&acc)[2][2][4][2], const Unit& u, int wr, int wc, int fr, int fq) const {
        const int row0 = u.pm * BM + wr * 64 + fr, col0 = u.pn * BM + wc * 32 + 4 * fq;
#pragma unroll
        for (int ai = 0; ai < 2; ++ai)
#pragma unroll
            for (int m = 0; m < 4; ++m) { float* rowp = C + (size_t)(row0 + ai * HALF + m * 16) * ldc + col0;
#pragma unroll
                for (int bj = 0; bj < 2; ++bj)
#pragma unroll
                    for (int n = 0; n < 2; ++n) *(f32x4*)(rowp + bj * HALF + n * 16) = acc[ai][bj][m][n]; }
    }
};
struct EpiBf16 {
    static constexpr bool PERM = true;
    bf16_t* O; int ldc;
    __device__ __forceinline__ void operator()(const f32x4 (&acc)[2][2][4][2], const Unit& u, int wr, int wc, int fr, int fq) const {
        const int row0 = u.pm * BM + wr * 64 + fr, col0 = u.pn * BM + wc * 32 + 8 * fq;
#pragma unroll
        for (int ai = 0; ai < 2; ++ai)
#pragma unroll
            for (int m = 0; m < 4; ++m) { bf16_t* rowp = O + (size_t)(row0 + ai * HALF + m * 16) * ldc + col0;
#pragma unroll
                for (int bj = 0; bj < 2; ++bj) { const f32x4 v0 = acc[ai][bj][m][0], v1 = acc[ai][bj][m][1];
                    u32x4 w; w.x = cvt_pk_bf16(v0[0], v0[1]); w.y = cvt_pk_bf16(v0[2], v0[3]); w.z = cvt_pk_bf16(v1[0], v1[1]); w.w = cvt_pk_bf16(v1[2], v1[3]);
                    *(u32x4*)(rowp + bj * HALF) = w; } }
    }
};
struct EpiSwiGLU {
    static constexpr bool PERM = true;
    bf16_t* O; int ldc;
    __device__ __forceinline__ void operator()(const f32x4 (&acc)[2][2][4][2], const Unit& u, int wr, int wc, int fr, int fq) const {
        const int row0 = u.pm * BM + wr * 64 + fr, col0 = u.pn * HALF + wc * 32 + 8 * fq;
#pragma unroll
        for (int ai = 0; ai < 2; ++ai)
#pragma unroll
            for (int m = 0; m < 4; ++m) { bf16_t* rowp = O + (size_t)(row0 + ai * HALF + m * 16) * ldc + col0;
                float o[8];
#pragma unroll
                for (int n = 0; n < 2; ++n)
#pragma unroll
                    for (int j = 0; j < 4; ++j) { const float g = acc[ai][0][m][n][j], up = acc[ai][1][m][n][j]; o[n * 4 + j] = g * __builtin_amdgcn_rcpf(1.0f + __expf(-g)) * up; }
                u32x4 w; w.x = cvt_pk_bf16(o[0], o[1]); w.y = cvt_pk_bf16(o[2], o[3]); w.z = cvt_pk_bf16(o[4], o[5]); w.w = cvt_pk_bf16(o[6], o[7]);
                *(u32x4*)(rowp) = w; }
    }
};

template <class Epi, class Sched>
__device__ __forceinline__ void gemm_phase(LAS unsigned char* lds, const Gemm g, const Sched& S, const Epi& E) {
    const int tid = threadIdx.x, wid = __builtin_amdgcn_readfirstlane(tid >> 6), lane = tid & 63, wr = wid >> 2, wc = wid & 3, fr = lane & 15, fq = lane >> 4;
    const int K = g.K, nt = K / BK;
    unsigned voffA[2], voffB[2];
#pragma unroll
    for (int i = 0; i < 2; ++i) { int R, C; stage_rc(tid * 16 + i * 8192, R, C); const int Rb = Epi::PERM ? ((R & ~31) + perm32(R & 31)) : R;
        voffA[i] = (unsigned)(R * K + C) * 2u; voffB[i] = (unsigned)(Rb * K + C) * 2u; }
    const size_t kstep = (size_t)(BK * 2);
    const size_t hstep = (size_t)HALF * K * 2;
    const size_t tstep = 2 * hstep;
    const unsigned ldsw = (unsigned)wid * 1024u;
    const int aoff = lds_byte(wr * 64 + fr, fq * 8), boff = lds_byte(wc * 32 + fr, fq * 8);
#define PG8_SA(b, h) (((b) * 2 + (h)) * HTB)
#define PG8_SB(b, h) ((4 + (b) * 2 + (h)) * HTB)
#define PG8_STAGE(bufoff, gbase, voff) do { _Pragma("unroll") for (int _i = 0; _i < 2; ++_i) \
        __builtin_amdgcn_global_load_lds((const unsigned*)((const char*)(gbase) + (voff)[_i]), (LAS unsigned*)(lds + (bufoff) + ldsw + _i * 8192), 16, 0, 0); } while (0)
#define PG8_LDA(dst, b, h) do { _Pragma("unroll") for (int m = 0; m < 4; ++m) _Pragma("unroll") for (int k = 0; k < 2; ++k) dst[m][k] = *(const LAS bf16x8*)(lds + PG8_SA(b, h) + aoff + m * 2048 + k * 1024); } while (0)
#define PG8_LDB(dst, b, h) do { _Pragma("unroll") for (int n = 0; n < 2; ++n) _Pragma("unroll") for (int k = 0; k < 2; ++k) dst[n][k] = *(const LAS bf16x8*)(lds + PG8_SB(b, h) + boff + n * 2048 + k * 1024); } while (0)
#define PG8_MMA(ai, bj, At, Bt) do { __builtin_amdgcn_s_setprio(1); _Pragma("unroll") for (int m = 0; m < 4; ++m) _Pragma("unroll") for (int n = 0; n < 2; ++n) _Pragma("unroll") for (int k = 0; k < 2; ++k) \
        acc[ai][bj][m][n] = __builtin_amdgcn_mfma_f32_16x16x32_bf16(Bt[n][k], At[m][k], acc[ai][bj][m][n], 0, 0, 0); __builtin_amdgcn_s_setprio(0); } while (0)
#define PG8_WAIT_V(n) asm volatile("s_waitcnt vmcnt(" #n ")" ::: "memory")
#define PG8_WAIT_L(n) asm volatile("s_waitcnt lgkmcnt(" #n ")" ::: "memory")
#define PG8_BAR __builtin_amdgcn_s_barrier()
#define PG8_SCHED __builtin_amdgcn_sched_barrier(0)
    Unit cur, nxt; int ui = 0;
    if (!S.next(0, cur)) return;
    f32x4 acc[2][2][4][2];
#pragma unroll
    for (int a = 0; a < 2; ++a)
#pragma unroll
        for (int b = 0; b < 2; ++b)
#pragma unroll
            for (int m = 0; m < 4; ++m)
#pragma unroll
                for (int n = 0; n < 2; ++n) acc[a][b][m][n] = (f32x4){0.f, 0.f, 0.f, 0.f};
    bf16x8 At[4][2], B0[2][2], B1[2][2];
    const char* cA = (const char*)g.A + (size_t)cur.pm * tstep; const char* cB = (const char*)g.Bt + (size_t)cur.pn * tstep;
    PG8_STAGE(PG8_SB(0, 0), cB, voffB); PG8_STAGE(PG8_SA(0, 0), cA, voffA); PG8_STAGE(PG8_SB(0, 1), cB + hstep, voffB); PG8_STAGE(PG8_SA(0, 1), cA + hstep, voffA);
    if (wr == 1) PG8_BAR;
    PG8_WAIT_V(4); PG8_BAR;
    PG8_STAGE(PG8_SB(1, 0), cB + kstep, voffB); PG8_STAGE(PG8_SA(1, 0), cA + kstep, voffA); PG8_STAGE(PG8_SB(1, 1), cB + hstep + kstep, voffB);
    PG8_WAIT_V(6); PG8_BAR;
    for (;;) {
        const bool has_next = S.next(ui + 1, nxt);
        const char* nA = has_next ? (const char*)g.A + (size_t)nxt.pm * tstep : cA; const char* nB = has_next ? (const char*)g.Bt + (size_t)nxt.pn * tstep : cB;
        for (int t = 0; t < nt; t += 2) {
            const bool last = (t == nt - 2);
            const char* a1 = cA + (size_t)(t + 1) * kstep;
            const char* a2 = last ? nA : cA + (size_t)(t + 2) * kstep; const char* b2 = last ? nB : cB + (size_t)(t + 2) * kstep;
            const char* a3 = a2 + kstep; const char* b3 = b2 + kstep;
            PG8_LDB(B0, 0, 0); PG8_SCHED; PG8_LDA(At, 0, 0); PG8_STAGE(PG8_SA(1, 1), a1 + hstep, voffA);
            PG8_WAIT_L(8); PG8_BAR; PG8_WAIT_L(0); PG8_MMA(0, 0, At, B0); PG8_BAR; PG8_SCHED;
            PG8_LDB(B1, 0, 1); PG8_STAGE(PG8_SB(0, 0), b2, voffB);
            PG8_BAR; PG8_WAIT_L(0); PG8_MMA(0, 1, At, B1); PG8_BAR;
            PG8_LDA(At, 0, 1); PG8_STAGE(PG8_SA(0, 0), a2, voffA);
            PG8_BAR; PG8_WAIT_L(0); PG8_MMA(1, 0, At, B0); PG8_BAR; PG8_SCHED;
            PG8_STAGE(PG8_SB(0, 1), b2 + hstep, voffB);
            PG8_WAIT_V(6); PG8_BAR; PG8_MMA(1, 1, At, B1); PG8_BAR;
            PG8_LDB(B0, 1, 0); PG8_SCHED; PG8_LDA(At, 1, 0); PG8_STAGE(PG8_SA(0, 1), a2 + hstep, voffA);
            PG8_WAIT_L(8); PG8_BAR; PG8_WAIT_L(0); PG8_MMA(0, 0, At, B0); PG8_BAR; PG8_SCHED;
            PG8_LDB(B1, 1, 1); PG8_STAGE(PG8_SB(1, 0), b3, voffB);
            PG8_BAR; PG8_WAIT_L(0); PG8_MMA(0, 1, At, B1); PG8_BAR;
            PG8_LDA(At, 1, 1); PG8_STAGE(PG8_SA(1, 0), a3, voffA);
            PG8_BAR; PG8_WAIT_L(0); PG8_MMA(1, 0, At, B0); PG8_BAR; PG8_SCHED;
            PG8_STAGE(PG8_SB(1, 1), b3 + hstep, voffB);
            PG8_WAIT_V(6); PG8_BAR; PG8_MMA(1, 1, At, B1); PG8_BAR;
        }
        E(acc, cur, wr, wc, fr, fq);
        if (!has_next) break;
#pragma unroll
        for (int a = 0; a < 2; ++a)
#pragma unroll
            for (int b = 0; b < 2; ++b)
#pragma unroll
                for (int m = 0; m < 4; ++m)
#pragma unroll
                    for (int n = 0; n < 2; ++n) acc[a][b][m][n] = (f32x4){0.f, 0.f, 0.f, 0.f};
        cur = nxt; cA = nA; cB = nB; ++ui;
    }
    PG8_WAIT_V(0);
    if (wr == 0) PG8_BAR;
    PG8_BAR;
#undef PG8_SA
#undef PG8_SB
#undef PG8_STAGE
#undef PG8_LDA
#undef PG8_LDB
#undef PG8_MMA
#undef PG8_WAIT_V
#undef PG8_WAIT_L
#undef PG8_BAR
#undef PG8_SCHED
}
}

struct WJob { const float* W; bf16_t* dst; int N, K, k0, n0, rowmode; };
constexpr int WT0 = 32 * 27, WT1 = WT0 + 32 * 8, WT2 = WT1 + 32 * 22, WT3 = WT2 + 32 * 22, WT4 = WT3 + 88 * 8;
__device__ __forceinline__ WJob wjob(const Params& p, int t) {
    WJob j;
    if (t < WT0) { j.W = p.w_in; j.dst = (bf16_t*)(p.ws + WS_WIN); j.N = PROJD; j.K = DM; j.k0 = (t / 27) * 64; j.n0 = (t % 27) * 256; j.rowmode = 0; }
    else if (t < WT1) { const int u = t - WT0; j.W = p.w_out; j.dst = (bf16_t*)(p.ws + WS_WOUT); j.N = DM; j.K = DM; j.k0 = (u / 8) * 64; j.n0 = (u % 8) * 256; j.rowmode = 0; }
    else if (t < WT2) { const int u = t - WT1; j.W = p.w_gate; j.dst = (bf16_t*)(p.ws + WS_WGU); j.N = DFF; j.K = DM; j.k0 = (u / 22) * 64; j.n0 = (u % 22) * 256; j.rowmode = 1; }
    else if (t < WT3) { const int u = t - WT2; j.W = p.w_up; j.dst = (bf16_t*)(p.ws + WS_WGU); j.N = DFF; j.K = DM; j.k0 = (u / 22) * 64; j.n0 = (u % 22) * 256; j.rowmode = 2; }
    else { const int u = t - WT3; j.W = p.w_down; j.dst = (bf16_t*)(p.ws + WS_WDN); j.N = DM; j.K = DFF; j.k0 = (u / 8) * 64; j.n0 = (u % 8) * 256; j.rowmode = 0; }
    return j;
}
__device__ __forceinline__ void wload(const WJob& j, f32x4 (&v)[8]) {
    const int tid = threadIdx.x, kk = tid >> 6, n = j.n0 + 4 * (tid & 63);
#pragma unroll
    for (int it = 0; it < 8; ++it) { v[it] = (f32x4){0.f, 0.f, 0.f, 0.f};
        if (n < j.N) v[it] = __builtin_nontemporal_load((const f32x4*)(j.W + (size_t)(j.k0 + kk + 8 * it) * j.N + n)); }
}
__device__ void weights_pass(const Params& p, LAS unsigned char* lds, int t_begin, int t_end, int worker, int nworkers) {
    LAS unsigned* tw = (LAS unsigned*)lds;
    const LAS bf16_t* th = (const LAS bf16_t*)lds;
    const int tid = threadIdx.x, kk = tid >> 6, n4 = tid & 63;
    int t = t_begin + worker;
    if (t >= t_end) return;
    f32x4 v[8];
    WJob cur = wjob(p, t);
    wload(cur, v);
    for (;;) {
#pragma unroll
        for (int it = 0; it < 8; ++it) { const int k = kk + 8 * it;
            tw[k * 129 + 2 * n4] = cvt_pk_bf16(v[it][0], v[it][1]); tw[k * 129 + 2 * n4 + 1] = cvt_pk_bf16(v[it][2], v[it][3]); }
        __syncthreads();
        const int tn = t + nworkers; const bool more = tn < t_end;
        WJob nxt = cur;
        if (more) { nxt = wjob(p, tn); wload(nxt, v); }
#pragma unroll
        for (int jj = 0; jj < 4; ++jj) {
            const int c = tid + 512 * jj, k8 = c & 7, nl = c >> 3, n = cur.n0 + nl;
            unsigned short e[8];
#pragma unroll
            for (int q = 0; q < 8; ++q) e[q] = th[(8 * k8 + q) * 258 + nl];
            if (n < cur.N) {
                int nr = n;
                if (cur.rowmode == 1) nr = 256 * (n >> 7) + (n & 127);
                else if (cur.rowmode == 2) nr = 256 * (n >> 7) + 128 + (n & 127);
                u32x4 w; w.x = (unsigned)e[0] | ((unsigned)e[1] << 16); w.y = (unsigned)e[2] | ((unsigned)e[3] << 16); w.z = (unsigned)e[4] | ((unsigned)e[5] << 16); w.w = (unsigned)e[6] | ((unsigned)e[7] << 16);
                *(u32x4*)(cur.dst + (size_t)nr * cur.K + cur.k0 + 8 * k8) = w;
            }
        }
        if (!more) break;
        __syncthreads();
        cur = nxt; t = tn;
    }
    __syncthreads();
}

__device__ void phase_prep(const Params& p, LAS unsigned char* lds) {
    const int tid = threadIdx.x, wid = tid >> 6, lane = tid & 63;
    bf16_t* win = (bf16_t*)(p.ws + WS_WIN);
    weights_pass(p, lds, 0, WT0, blockIdx.x, gridDim.x);
    const size_t gt = (size_t)blockIdx.x * 512 + tid, ngt = (size_t)gridDim.x * 512;
    {
        u32x4 z = {0u, 0u, 0u, 0u};
        u32x4* a = (u32x4*)(win + (size_t)PROJD * DM); const size_t na = (size_t)(PROJP - PROJD) * DM * 2 / 16;
        for (size_t i = gt; i < na; i += ngt) a[i] = z;
        u32x4* b = (u32x4*)((bf16_t*)(p.ws + WS_ABUF) + (size_t)MTOT * DM); const size_t nb = (size_t)(MPAD - MTOT) * DM * 2 / 16;
        for (size_t i = gt; i < nb; i += ngt) b[i] = z;
    }
    {
        float* tab = (float*)(p.ws + WS_TAB);
        for (size_t i = gt; i < (size_t)TABROWS * 128; i += ngt) {
            const int pi = (int)(i >> 7), f = (int)(i & 127);
            const float pos = pi < LP ? (float)pi : 16384.0f;
            const float inv = exp2f(-(float)f * (13.287712379549449f / 128.0f));
            const float ang = pos * inv;
            const double a = (double)ang;
            const double n = rint(a * 0.15915494309189535);
            double r = fma(-n, 6.283185307179586, a); r = fma(-n, 2.4492935982947064e-16, r);
            const float rf = (float)r;
            tab[(size_t)pi * 256 + f] = cosf(rf); tab[(size_t)pi * 256 + 128 + f] = sinf(rf);
        }
    }
    {
        bf16_t* U = (bf16_t*)(p.ws + WS_ABUF);
        float4 gpre[8];
#pragma unroll
        for (int q = 0; q < 8; ++q) gpre[q] = *(const float4*)(p.pre_mix_g + q * 256 + lane * 4);
        for (int row = blockIdx.x * 8 + wid; row < MTOT; row += gridDim.x * 8) {
            const float* x = src_row(p, row);
            float4 v[8]; float ss = 0.f;
#pragma unroll
            for (int q = 0; q < 8; ++q) { v[q] = *(const float4*)(x + q * 256 + lane * 4); ss += v[q].x * v[q].x + v[q].y * v[q].y + v[q].z * v[q].z + v[q].w * v[q].w; }
            ss = wave_sum(ss);
            const float rs = rsqrtf(ss * (1.0f / DM) + EPS);
#pragma unroll
            for (int q = 0; q < 8; ++q) { const int col = q * 256 + lane * 4; const float4 g = gpre[q];
                u32x2 w; w.x = pack2(v[q].x * rs * g.x, v[q].y * rs * g.y); w.y = pack2(v[q].z * rs * g.z, v[q].w * rs * g.w);
                *(u32x2*)(U + (size_t)row * DM + col) = w; }
        }
    }
}

__device__ void phase_convrope(const Params& p) {
    const bf16_t* __restrict__ proj = (const bf16_t*)(p.ws + WS_PROJ);
    bf16_t* projw = (bf16_t*)(p.ws + WS_PROJ);
    bf16_t* __restrict__ XC = (bf16_t*)(p.ws + WS_XC);
    const float* __restrict__ tab = (const float*)(p.ws + WS_TAB);
    const unsigned gt = blockIdx.x * 512 + threadIdx.x, ngt = gridDim.x * 512;
#pragma unroll 2
    for (unsigned i = gt; i < (unsigned)(NBATCH * 516 * 192); i += ngt) {
        const int oct = i % 192, tg = (i / 192) % 516, b = i / (192 * 516), t0 = tg * 4, ch = oct * 8;
        if (t0 < NMETA && b > 0) continue;
        u32x4 rin[7];
#pragma unroll
        for (int rr = 0; rr < 7; ++rr) { const int t = t0 - 3 + rr;
            rin[rr] = (u32x4){0u, 0u, 0u, 0u};
            if (t >= 0) rin[rr] = *(const u32x4*)(proj + (unsigned)(prow(b, t) * PROJP + OX + ch)); }
        u32x4 o[4];
#pragma unroll
        for (int e2 = 0; e2 < 4; ++e2) {
            const float2 w0 = *(const float2*)(p.conv_w + 0 * CONVD + ch + 2 * e2), w1 = *(const float2*)(p.conv_w + 1 * CONVD + ch + 2 * e2);
            const float2 w2 = *(const float2*)(p.conv_w + 2 * CONVD + ch + 2 * e2), w3 = *(const float2*)(p.conv_w + 3 * CONVD + ch + 2 * e2);
            const float2 bb = *(const float2*)(p.conv_b + ch + 2 * e2);
#pragma unroll
            for (int r = 0; r < 4; ++r) {
                const float v0 = bb.x + w0.x * lo16(rin[r][e2]) + w1.x * lo16(rin[r + 1][e2]) + w2.x * lo16(rin[r + 2][e2]) + w3.x * lo16(rin[r + 3][e2]);
                const float v1 = bb.y + w0.y * hi16(rin[r][e2]) + w1.y * hi16(rin[r + 1][e2]) + w2.y * hi16(rin[r + 2][e2]) + w3.y * hi16(rin[r + 3][e2]);
                o[r][e2] = cvt_pk_bf16(silu_f(v0), silu_f(v1));
            }
        }
#pragma unroll
        for (int r = 0; r < 4; ++r) *(u32x4*)(XC + (unsigned)(prow(b, t0 + r) * CONVD + ch)) = o[r];
    }
    for (unsigned i = gt; i < (unsigned)(DECB * 192); i += ngt) {
        const int s = i / 192, ch = (i % 192) * 8;
        const float* sc = p.state_conv + (size_t)s * 3 * CONVD + ch;
        const u32x4 cur = *(const u32x4*)(proj + (unsigned)((SROW0 + s) * PROJP + OX + ch));
        float* oc = p.out + O_SCONV + (size_t)s * 3 * CONVD + ch;
        u32x4 o;
#pragma unroll
        for (int e4 = 0; e4 < 2; ++e4) {
            const float4 i0 = *(const float4*)(sc + 4 * e4), i1 = *(const float4*)(sc + CONVD + 4 * e4), i2 = *(const float4*)(sc + 2 * CONVD + 4 * e4);
            const float4 i3 = make_float4(lo16(cur[2 * e4]), hi16(cur[2 * e4]), lo16(cur[2 * e4 + 1]), hi16(cur[2 * e4 + 1]));
            const float4 w0 = *(const float4*)(p.conv_w + ch + 4 * e4), w1 = *(const float4*)(p.conv_w + CONVD + ch + 4 * e4);
            const float4 w2 = *(const float4*)(p.conv_w + 2 * CONVD + ch + 4 * e4), w3 = *(const float4*)(p.conv_w + 3 * CONVD + ch + 4 * e4);
            const float4 bb = *(const float4*)(p.conv_b + ch + 4 * e4);
            const float v0 = bb.x + w0.x * i0.x + w1.x * i1.x + w2.x * i2.x + w3.x * i3.x, v1 = bb.y + w0.y * i0.y + w1.y * i1.y + w2.y * i2.y + w3.y * i3.y;
            const float v2 = bb.z + w0.z * i0.z + w1.z * i1.z + w2.z * i2.z + w3.z * i3.z, v3 = bb.w + w0.w * i0.w + w1.w * i1.w + w2.w * i2.w + w3.w * i3.w;
            o[2 * e4] = cvt_pk_bf16(silu_f(v0), silu_f(v1)); o[2 * e4 + 1] = cvt_pk_bf16(silu_f(v2), silu_f(v3));
            *(float4*)(oc + 4 * e4) = i1; *(float4*)(oc + CONVD + 4 * e4) = i2; *(float4*)(oc + 2 * CONVD + 4 * e4) = i3;
        }
        *(u32x4*)(XC + (unsigned)((SROW0 + s) * CONVD + ch)) = o;
    }
    for (unsigned i = gt; i < (unsigned)(MTOT * 64); i += ngt) {
        const int row = i >> 6, hd = (i >> 4) & 3, d8 = i & 15;
        const int trow = row < MMAIN ? (row & (SEQL - 1)) + NMETA : (row < MROW0 ? LP : row - MROW0);
        bf16_t* base = projw + (unsigned)(row * PROJP + hd * 256 + 8 * d8);
        const u32x4 q1 = *(const u32x4*)(base + OQ), q2 = *(const u32x4*)(base + OQ + 128), k1 = *(const u32x4*)(base + OKK), k2 = *(const u32x4*)(base + OKK + 128);
        const float* tp = tab + (unsigned)(trow * 256 + 8 * d8);
        const f32x4 c0 = *(const f32x4*)(tp), c1 = *(const f32x4*)(tp + 4), s0 = *(const f32x4*)(tp + 128), s1 = *(const f32x4*)(tp + 132);
        const float cc[8] = {c0[0], c0[1], c0[2], c0[3], c1[0], c1[1], c1[2], c1[3]}, sn[8] = {s0[0], s0[1], s0[2], s0[3], s1[0], s1[1], s1[2], s1[3]};
        u32x4 qlo, qhi, klo, khi;
#pragma unroll
        for (int e = 0; e < 4; ++e) {
            const float a0 = lo16(q1[e]), a1 = hi16(q1[e]), b0 = lo16(q2[e]), b1 = hi16(q2[e]);
            qlo[e] = cvt_pk_bf16(a0 * cc[2 * e] - b0 * sn[2 * e], a1 * cc[2 * e + 1] - b1 * sn[2 * e + 1]);
            qhi[e] = cvt_pk_bf16(a0 * sn[2 * e] + b0 * cc[2 * e], a1 * sn[2 * e + 1] + b1 * cc[2 * e + 1]);
            const float x0 = lo16(k1[e]), x1 = hi16(k1[e]), y0 = lo16(k2[e]), y1 = hi16(k2[e]);
            klo[e] = cvt_pk_bf16((x0 * cc[2 * e] - y0 * sn[2 * e]) * 0.0625f, (x1 * cc[2 * e + 1] - y1 * sn[2 * e + 1]) * 0.0625f);
            khi[e] = cvt_pk_bf16((x0 * sn[2 * e] + y0 * cc[2 * e]) * 0.0625f, (x1 * sn[2 * e + 1] + y1 * cc[2 * e + 1]) * 0.0625f);
        }
        *(u32x4*)(base + OQ) = qlo; *(u32x4*)(base + OQ + 128) = qhi; *(u32x4*)(base + OKK) = klo; *(u32x4*)(base + OKK + 128) = khi;
    }
    for (unsigned i = gt; i < (unsigned)(NBATCH * 3 * CONVD); i += ngt) {
        const int b = i / (3 * CONVD), r = (i / CONVD) % 3, c = i % CONVD;
        p.out[O_PCONV + i] = bf2f(proj[(unsigned)((b * SEQL + SEQL - 3 + r) * PROJP + OX + c)]);
    }
}

__device__ __forceinline__ int step_row(int b, int step, int i) { return step == 0 ? MROW0 + i : b * SEQL + 64 * (step - 1) + i; }

constexpr int SMP_OFF = 104448;
constexpr int SMP_XC = 0, SMP_ZV = 768, SMP_HP = 1280, SMP_Q = 1312, SMP_K = 1824, SMP_V = 2336, SMP_RED = 2848, SMP_FLOATS = 2848 + 2048;
constexpr int NSLICE = 24;
static_assert(SMP_OFF + SMP_FLOATS * 4 <= LDS_ST, "sample block does not fit");

__device__ __forceinline__ void sample_setup(const Params& p, LAS float* sm, int s, int hf) {
    const int tid = threadIdx.x;
    const bf16_t* prw = (const bf16_t*)(p.ws + WS_PROJ) + (size_t)(SROW0 + s) * PROJP;
    const bf16_t* xcr = (const bf16_t*)(p.ws + WS_XC) + (size_t)(SROW0 + s) * CONVD;
    for (int li = tid; li < 768; li += 512) {
        const int c = li < 512 ? hf * 512 + li : (li < 640 ? 1024 + hf * 128 + (li - 512) : 1280 + hf * 128 + (li - 640));
        sm[SMP_XC + li] = bf2f(xcr[c]);
    }
    sm[SMP_ZV + tid] = bf2f(prw[OZ + hf * 512 + tid]);
    if (tid < 8) { const int h = hf * 8 + tid;
        const float dt = softplus_f(bf2f(prw[ODT + h]) + p.dt_bias[h]);
        sm[SMP_HP + tid * 4 + 0] = dt; sm[SMP_HP + tid * 4 + 1] = __expf(-dt * __expf(p.a_log[h])); sm[SMP_HP + tid * 4 + 2] = p.d_skip[h]; }
    { const int r2 = tid >> 8, d = tid & 255, hd = hf * 2 + r2;
      sm[SMP_Q + tid] = bf2f(prw[OQ + hd * 256 + d]); sm[SMP_K + tid] = bf2f(prw[OKK + hd * 256 + d]); sm[SMP_V + tid] = bf2f(prw[OV + hd * 256 + d]); }
}
__device__ __forceinline__ void sample_issue(const Params& p, int s, int hf, int slice, f32x4 (&r)[4]) {
    const int tid = threadIdx.x;
    if (slice < 8) {
        const float* hin = p.state_ssm + ((size_t)s * 16 + hf * 8 + slice) * 64 * 128 + (size_t)(tid >> 5) * 128 + 4 * (tid & 31);
#pragma unroll
        for (int i = 0; i < 4; ++i) r[i] = __builtin_nontemporal_load((const f32x4*)(hin + (size_t)i * 16 * 128));
    } else {
        const int r2 = (slice - 8) >> 3, part = (slice - 8) & 7;
        const float* sin_ = p.state_ret + ((size_t)s * 4 + hf * 2 + r2) * 256 * 256 + (size_t)((tid >> 6) + 32 * part) * 256 + 4 * (tid & 63);
#pragma unroll
        for (int i = 0; i < 4; ++i) r[i] = __builtin_nontemporal_load((const f32x4*)(sin_ + (size_t)i * 8 * 256));
    }
}
__device__ __forceinline__ void sample_process(const Params& p, LAS float* sm, int s, int hf, int slice, const f32x4 (&r)[4], f32x4& ya) {
    const int tid = threadIdx.x;
    if (slice < 8) {
        const int n4 = tid & 31, pbase = tid >> 5, h = hf * 8 + slice;
        const f32x4 Bq = *(const LAS f32x4*)(sm + SMP_XC + 512 + 4 * n4), Cq = *(const LAS f32x4*)(sm + SMP_XC + 640 + 4 * n4);
        const float dt = sm[SMP_HP + slice * 4], dec = sm[SMP_HP + slice * 4 + 1], dsk = sm[SMP_HP + slice * 4 + 2];
        float* hout = p.out + O_SSSM + ((size_t)s * 16 + h) * 64 * 128 + (size_t)pbase * 128 + 4 * n4;
        bf16_t* Y = (bf16_t*)(p.ws + WS_TMP) + (size_t)(SROW0 + s) * DM;
        float yp[4], xs[4];
#pragma unroll
        for (int i = 0; i < 4; ++i) {
            const int pp = pbase + 16 * i;
            xs[i] = sm[SMP_XC + slice * 64 + pp];
            const float dx = dt * xs[i];
            const f32x4 hn = dec * r[i] + dx * Bq;
            *(f32x4*)(hout + (size_t)i * 16 * 128) = hn;
            yp[i] = Cq[0] * hn[0] + Cq[1] * hn[1] + Cq[2] * hn[2] + Cq[3] * hn[3];
        }
        const bool b4 = (n4 & 16) != 0, b3 = (n4 & 8) != 0;
        const float t0 = __shfl_xor(b4 ? yp[0] : yp[2], 16), t1 = __shfl_xor(b4 ? yp[1] : yp[3], 16);
        const float a0 = (b4 ? yp[2] : yp[0]) + t0, a1 = (b4 ? yp[3] : yp[1]) + t1;
        float bsum = (b3 ? a1 : a0) + __shfl_xor(b3 ? a0 : a1, 8);
        bsum += __shfl_xor(bsum, 4); bsum += __shfl_xor(bsum, 2); bsum += __shfl_xor(bsum, 1);
        if ((n4 & 7) == 0) {
            const int i = (b4 ? 2 : 0) + (b3 ? 1 : 0), pp = pbase + 16 * i;
            const float xv = b4 ? (b3 ? xs[3] : xs[2]) : (b3 ? xs[1] : xs[0]);
            Y[h * 64 + pp] = f2bf((bsum + dsk * xv) * silu_f(sm[SMP_ZV + slice * 64 + pp]));
        }
    } else {
        const int r2 = (slice - 8) >> 3, part = (slice - 8) & 7, hd = hf * 2 + r2, v4 = tid & 63, d0 = (tid >> 6) + 32 * part;
        const float gam = __expf(hd == 0 ? p.lg0 : hd == 1 ? p.lg1 : hd == 2 ? p.lg2 : p.lg3);
        const f32x4 vq = *(const LAS f32x4*)(sm + SMP_V + r2 * 256 + 4 * v4);
        float* sout = p.out + O_SRET + ((size_t)s * 4 + hd) * 256 * 256 + (size_t)d0 * 256 + 4 * v4;
        if (part == 0) ya = (f32x4){0.f, 0.f, 0.f, 0.f};
#pragma unroll
        for (int i = 0; i < 4; ++i) {
            const int d = d0 + 8 * i;
            const float kd = sm[SMP_K + r2 * 256 + d], qd = sm[SMP_Q + r2 * 256 + d];
            const f32x4 sn = gam * r[i] + kd * vq;
            __builtin_nontemporal_store(sn, (f32x4*)(sout + (size_t)i * 8 * 256));
            ya += qd * sn;
        }
        if (part == 7) *(LAS f32x4*)(sm + SMP_RED + (tid >> 6) * 256 + 4 * v4) = ya;
    }
}
__device__ __forceinline__ void sample_finalize(const Params& p, LAS float* sm, int s, int hf, int r2) {
    const int tid = threadIdx.x;
    if (tid < 256) { float a = 0.f;
#pragma unroll
        for (int w = 0; w < 8; ++w) a += sm[SMP_RED + w * 256 + tid];
        ((bf16_t*)(p.ws + WS_TMP))[(size_t)(SROW0 + s) * DM + 1024 + (hf * 2 + r2) * 256 + tid] = f2bf(a); }
}

__device__ void ret_task(const Params& p, LAS unsigned char* lds, int b, int hd, int sl, int smp, int shf) {
    const int tid = threadIdx.x, wid = tid >> 6, lane = tid & 63, fr = lane & 15, fq = lane >> 4;
    LAS bf16_t* Qs = (LAS bf16_t*)lds;
    LAS bf16_t* Ks = Qs + 64 * 264;
    LAS bf16_t* Ps = Ks + 64 * 264;
    LAS bf16_t* Vs = Ps + 64 * 72;
    LAS bf16_t* Vw = Vs + 64 * 40;
    LAS bf16_t* St = Vw + 64 * 40;
    const bf16_t* proj = (const bf16_t*)(p.ws + WS_PROJ);
    bf16_t* Y = (bf16_t*)(p.ws + WS_TMP);
    const float lg = hd == 0 ? p.lg0 : hd == 1 ? p.lg1 : hd == 2 ? p.lg2 : p.lg3;
    for (int i = tid; i < 32 * 264 / 2; i += 512) ((LAS unsigned*)St)[i] = 0u;
    f32x4 sacc[4];
#pragma unroll
    for (int i = 0; i < 4; ++i) sacc[i] = (f32x4){0.f, 0.f, 0.f, 0.f};
    u32x4 rq[4], rk[4], rv;
    const int crow = tid >> 5, cch = tid & 31, vrow = tid >> 2, v8 = tid & 3;
    auto issue = [&](int step) {
        const int nv = step == 0 ? NMETA : 64;
#pragma unroll
        for (int i = 0; i < 4; ++i) { const int row = crow + 16 * i;
            rq[i] = (u32x4){0u, 0u, 0u, 0u}; rk[i] = rq[i];
            if (row < nv) { const bf16_t* base = proj + (unsigned)(step_row(b, step, row) * PROJP + hd * 256 + 8 * cch);
                rq[i] = *(const u32x4*)(base + OQ); rk[i] = *(const u32x4*)(base + OKK); } }
        rv = (u32x4){0u, 0u, 0u, 0u};
        if (tid < 256 && vrow < nv) rv = *(const u32x4*)(proj + (unsigned)(step_row(b, step, vrow) * PROJP + OV + hd * 256 + sl * 32 + 8 * v8));
    };
    LAS float* sm = (LAS float*)(lds + SMP_OFF);
    sample_setup(p, sm, smp, shf);
    f32x4 sr[4]; f32x4 sya = {0.f, 0.f, 0.f, 0.f};
    issue(0);
    __syncthreads();
    for (int step = 0; step < NSTEP; ++step) {
        const int nv = step == 0 ? NMETA : 64;
#pragma unroll
        for (int i = 0; i < 4; ++i) { const int row = crow + 16 * i;
            *(LAS u32x4*)(Qs + row * 264 + 8 * cch) = rq[i]; *(LAS u32x4*)(Ks + row * 264 + 8 * cch) = rk[i]; }
        if (tid < 256) {
            const float wk = __expf((float)(nv - 1 - vrow) * lg);
            u32x4 vw;
#pragma unroll
            for (int e = 0; e < 4; ++e) vw[e] = pack2(lo16(rv[e]) * wk, hi16(rv[e]) * wk);
            *(LAS u32x4*)(Vs + vrow * 40 + 8 * v8) = rv; *(LAS u32x4*)(Vw + vrow * 40 + 8 * v8) = vw;
        }
        __syncthreads();
        if (step == 16 || step == 24) sample_finalize(p, sm, smp, shf, step == 16 ? 0 : 1);
        if (step + 1 < NSTEP) issue(step + 1);
        if (step < NSLICE) sample_issue(p, smp, shf, step, sr);
        const int ib = wid >> 1, vb = wid & 1;
        f32x4 acc3 = {0.f, 0.f, 0.f, 0.f};
        {
            f32x4 sc[2]; sc[0] = (f32x4){0.f, 0.f, 0.f, 0.f}; sc[1] = sc[0];
            const int jb0 = 2 * vb;
            mma16x3<256>(sc[0], sc[1], acc3, Qs + ib * 16 * 264, Ks + jb0 * 16 * 264, Ks + (jb0 + 1) * 16 * 264, St + vb * 16 * 264, 264, fr, fq);
#pragma unroll
            for (int tt = 0; tt < 2; ++tt) {
                const int jb = jb0 + tt;
#pragma unroll
                for (int r = 0; r < 4; ++r) { const int i = ib * 16 + fq * 4 + r, j = jb * 16 + fr;
                    const float val = (j <= i) ? sc[tt][r] * __expf((float)(i - j) * lg) : 0.f;
                    Ps[i * 72 + j] = f2bf(val); }
            }
        }
        __syncthreads();
        f32x4 acc2 = {0.f, 0.f, 0.f, 0.f};
#pragma unroll
        for (int k0 = 0; k0 < 64; k0 += 32) acc2 = MFMA16(ld_row(Ps + ib * 16 * 72, 72, k0, fr, fq), ld_tr(Vs + vb * 16, 40, k0, fr, fq), acc2);
        if (step > 0) {
#pragma unroll
            for (int r = 0; r < 4; ++r) { const int i = ib * 16 + fq * 4 + r;
                Y[(unsigned)(step_row(b, step, i) * DM + 1024 + hd * 256 + sl * 32 + vb * 16 + fr)] = f2bf(acc2[r] + __expf((float)(i + 1) * lg) * acc3[r]); }
        }
        const float dec = __expf((float)nv * lg);
#pragma unroll
        for (int tt = 0; tt < 4; ++tt) {
            const int db = 2 * wid + (tt >> 1), vb2 = tt & 1;
            sacc[tt] *= dec;
#pragma unroll
            for (int k0 = 0; k0 < 64; k0 += 32) sacc[tt] = MFMA16(ld_tr(Ks + db * 16, 264, k0, fr, fq), ld_tr(Vw + vb2 * 16, 40, k0, fr, fq), sacc[tt]);
        }
        if (step < NSLICE) sample_process(p, sm, smp, shf, step, sr, sya);
        __syncthreads();
#pragma unroll
        for (int tt = 0; tt < 4; ++tt) {
            const int db = 2 * wid + (tt >> 1), vb2 = tt & 1;
            u32x2 w; w.x = pack2(sacc[tt][0], sacc[tt][1]); w.y = pack2(sacc[tt][2], sacc[tt][3]);
            *(LAS u32x2*)(St + (vb2 * 16 + fr) * 264 + db * 16 + fq * 4) = w;
        }
    }
    float* o = p.out + O_PRET + (size_t)(b * 4 + hd) * 256 * 256;
#pragma unroll
    for (int tt = 0; tt < 4; ++tt) { const int db = 2 * wid + (tt >> 1), vb2 = tt & 1;
#pragma unroll
        for (int r = 0; r < 4; ++r) o[(size_t)(db * 16 + fq * 4 + r) * 256 + sl * 32 + vb2 * 16 + fr] = sacc[tt][r]; }
}

__device__ void ssd_task(const Params& p, LAS unsigned char* lds, int b, int h, int ph, int smp, int shf) {
    const int tid = threadIdx.x, wid = tid >> 6, lane = tid & 63, fr = lane & 15, fq = lane >> 4, g = h >> 3;
    LAS bf16_t* Cs = (LAS bf16_t*)lds;
    LAS bf16_t* Bs = Cs + 64 * 136;
    LAS bf16_t* Bw = Bs + 64 * 136;
    LAS bf16_t* Ps = Bw + 64 * 136;
    LAS bf16_t* Xs = Ps + 64 * 72;
    LAS bf16_t* Hs = Xs + 64 * 40;
    LAS float* dtA = (LAS float*)(Hs + 32 * 136);
    LAS float* lcA = dtA + NSTEP * 64;
    const bf16_t* proj = (const bf16_t*)(p.ws + WS_PROJ);
    const bf16_t* XC = (const bf16_t*)(p.ws + WS_XC);
    bf16_t* Y = (bf16_t*)(p.ws + WS_TMP);
    const float a_neg = -__expf(p.a_log[h]), dtb = p.dt_bias[h], dsk = p.d_skip[h];
    for (int step = wid; step < NSTEP; step += 8) {
        const int nv = step == 0 ? NMETA : 64;
        float dt = 0.f;
        if (lane < nv) dt = softplus_f(bf2f(proj[(unsigned)(step_row(b, step, lane) * PROJP + ODT + h)]) + dtb);
        float x = dt * a_neg;
#pragma unroll
        for (int o = 1; o < 64; o <<= 1) { const float y = __shfl_up(x, o); if (lane >= o) x += y; }
        dtA[step * 64 + lane] = dt; lcA[step * 64 + lane] = x;
    }
    for (int i = tid; i < 32 * 136 / 2; i += 512) ((LAS unsigned*)Hs)[i] = 0u;
    f32x4 hacc[2];
    hacc[0] = (f32x4){0.f, 0.f, 0.f, 0.f}; hacc[1] = hacc[0];
    u32x4 rb[2], rc[2], rx; bf16_t rz[4] = {0, 0, 0, 0};
    const int brow = tid >> 4, bch = tid & 15, xrow = tid >> 2, x8 = tid & 3;
    auto issue = [&](int step) {
        const int nv = step == 0 ? NMETA : 64;
#pragma unroll
        for (int i = 0; i < 2; ++i) { const int row = brow + 32 * i;
            rb[i] = (u32x4){0u, 0u, 0u, 0u}; rc[i] = rb[i];
            if (row < nv) { const bf16_t* base = XC + (unsigned)(step_row(b, step, row) * CONVD + g * 128 + 8 * bch);
                rb[i] = *(const u32x4*)(base + 1024); rc[i] = *(const u32x4*)(base + 1280); } }
        rx = (u32x4){0u, 0u, 0u, 0u};
        if (tid < 256 && xrow < nv) rx = *(const u32x4*)(XC + (unsigned)(step_row(b, step, xrow) * CONVD + h * 64 + ph * 32 + 8 * x8));
        if (step > 0) {
#pragma unroll
            for (int r = 0; r < 4; ++r) rz[r] = proj[(unsigned)(step_row(b, step, (wid >> 1) * 16 + fq * 4 + r) * PROJP + OZ + h * 64 + ph * 32 + (wid & 1) * 16 + fr)];
        }
    };
    LAS float* sm = (LAS float*)(lds + SMP_OFF);
    sample_setup(p, sm, smp, shf);
    f32x4 sr[4]; f32x4 sya = {0.f, 0.f, 0.f, 0.f};
    issue(0);
    __syncthreads();
    for (int step = 0; step < NSTEP; ++step) {
        const LAS float* dtS = dtA + step * 64; const LAS float* lcS = lcA + step * 64;
        const float lc_last = lcS[63];
#pragma unroll
        for (int i = 0; i < 2; ++i) { const int row = brow + 32 * i;
            const float wts = __expf(lc_last - lcS[row]) * dtS[row];
            u32x4 w;
#pragma unroll
            for (int e = 0; e < 4; ++e) w[e] = pack2(lo16(rb[i][e]) * wts, hi16(rb[i][e]) * wts);
            *(LAS u32x4*)(Bs + row * 136 + 8 * bch) = rb[i]; *(LAS u32x4*)(Bw + row * 136 + 8 * bch) = w; *(LAS u32x4*)(Cs + row * 136 + 8 * bch) = rc[i]; }
        if (tid < 256) *(LAS u32x4*)(Xs + xrow * 40 + 8 * x8) = rx;
        __syncthreads();
        if (step == 16 || step == 24) sample_finalize(p, sm, smp, shf, step == 16 ? 0 : 1);
        float zc[4];
#pragma unroll
        for (int r = 0; r < 4; ++r) zc[r] = bf2f(rz[r]);
        if (step + 1 < NSTEP) issue(step + 1);
        if (step < NSLICE) sample_issue(p, smp, shf, step, sr);
        const int ib = wid >> 1, pb = wid & 1;
        f32x4 acc3 = {0.f, 0.f, 0.f, 0.f};
        {
            f32x4 sc[2]; sc[0] = (f32x4){0.f, 0.f, 0.f, 0.f}; sc[1] = sc[0];
            const int jb0 = 2 * pb;
            mma16x3<128>(sc[0], sc[1], acc3, Cs + ib * 16 * 136, Bs + jb0 * 16 * 136, Bs + (jb0 + 1) * 16 * 136, Hs + pb * 16 * 136, 136, fr, fq);
#pragma unroll
            for (int tt = 0; tt < 2; ++tt) {
                const int j = (jb0 + tt) * 16 + fr; const float lcj = lcS[j], dtj = dtS[j];
#pragma unroll
                for (int r = 0; r < 4; ++r) { const int i = ib * 16 + fq * 4 + r;
                    const float val = (j <= i) ? sc[tt][r] * __expf(lcS[i] - lcj) * dtj : 0.f;
                    Ps[i * 72 + j] = f2bf(val); }
            }
        }
        __syncthreads();
        f32x4 acc2 = {0.f, 0.f, 0.f, 0.f};
#pragma unroll
        for (int k0 = 0; k0 < 64; k0 += 32) acc2 = MFMA16(ld_row(Ps + ib * 16 * 72, 72, k0, fr, fq), ld_tr(Xs + pb * 16, 40, k0, fr, fq), acc2);
        if (step > 0) {
#pragma unroll
            for (int r = 0; r < 4; ++r) { const int i = ib * 16 + fq * 4 + r, pl = pb * 16 + fr;
                const float xv = bf2f(Xs[i * 40 + pl]);
                const float yv = acc2[r] + __expf(lcS[i]) * acc3[r] + dsk * xv;
                const unsigned grow = (unsigned)step_row(b, step, i);
                const float z = zc[r];
                Y[grow * DM + h * 64 + ph * 32 + pl] = f2bf(yv * silu_f(z)); }
        }
        const float dec = __expf(lc_last);
#pragma unroll
        for (int tt = 0; tt < 2; ++tt) {
            hacc[tt] *= dec;
#pragma unroll
            for (int k0 = 0; k0 < 64; k0 += 32) hacc[tt] = MFMA16(ld_tr(Xs + tt * 16, 40, k0, fr, fq), ld_tr(Bw + wid * 16, 136, k0, fr, fq), hacc[tt]);
        }
        if (step < NSLICE) sample_process(p, sm, smp, shf, step, sr, sya);
        __syncthreads();
#pragma unroll
        for (int tt = 0; tt < 2; ++tt)
#pragma unroll
            for (int r = 0; r < 4; ++r) Hs[(tt * 16 + fq * 4 + r) * 136 + wid * 16 + fr] = f2bf(hacc[tt][r]);
    }
    float* o = p.out + O_PSSM + (size_t)(b * 16 + h) * 64 * 128;
#pragma unroll
    for (int tt = 0; tt < 2; ++tt)
#pragma unroll
        for (int r = 0; r < 4; ++r) o[(size_t)(ph * 32 + tt * 16 + fq * 4 + r) * 128 + wid * 16 + fr] = hacc[tt][r];
}

__device__ void phase_mixers(const Params& p, LAS unsigned char* lds) {
    for (int t = blockIdx.x; t < 128; t += gridDim.x) {
        const int x = t & 7, k = t >> 3, task = (x * 2 + (k >> 3)) * 8 + (k & 7);
        ret_task(p, lds, task >> 5, (task >> 3) & 3, task & 7, t >> 1, t & 1);
        __syncthreads();
    }
    for (int t = blockIdx.x; t < 256; t += gridDim.x) {
        if (t >= 128) { const int tt = t - 128, u = (tt & 7) * 16 + (tt >> 3); ssd_task(p, lds, u >> 5, (u >> 1) & 15, u & 1, t >> 1, t & 1); __syncthreads(); }
    }
}

__device__ void aux_gemm(const bf16_t* __restrict__ A, int lda, const bf16_t* __restrict__ Bt, int K, float* __restrict__ C0, float* __restrict__ C1) {
    const int tid = threadIdx.x, wid = tid >> 6, lane = tid & 63, fr = lane & 15, fq = lane >> 4;
    for (int task = blockIdx.x; task < 256; task += gridDim.x) {
        const int cb = task & 127, kh = task >> 7, Kh = K >> 1;
        const bf16_t* ap = A + (size_t)(16 * wid + fr) * lda + kh * Kh + 8 * fq;
        const bf16_t* bp = Bt + (size_t)(cb * 16 + fr) * K + kh * Kh + 8 * fq;
        f32x4 acc0 = {0.f, 0.f, 0.f, 0.f}, acc1 = acc0;
#pragma unroll 4
        for (int k = 0; k < Kh; k += 64) {
            const bf16x8 a0 = *(const bf16x8*)(ap + k), b0 = *(const bf16x8*)(bp + k);
            const bf16x8 a1 = *(const bf16x8*)(ap + k + 32), b1 = *(const bf16x8*)(bp + k + 32);
            acc0 = MFMA16(a0, b0, acc0); acc1 = MFMA16(a1, b1, acc1);
        }
        float* C = kh ? C1 : C0;
#pragma unroll
        for (int r = 0; r < 4; ++r) C[(size_t)(16 * wid + fq * 4 + r) * DM + cb * 16 + fr] = acc0[r] + acc1[r];
    }
}

__device__ __forceinline__ void wave_sum8(float (&s)[8]) {
    const int lane = threadIdx.x & 63; const bool b5 = (lane & 32) != 0, b4 = (lane & 16) != 0, b3 = (lane & 8) != 0;
    float a[4], c[2];
#pragma unroll
    for (int k = 0; k < 4; ++k) a[k] = (b5 ? s[k + 4] : s[k]) + __shfl_xor(b5 ? s[k] : s[k + 4], 32);
#pragma unroll
    for (int k = 0; k < 2; ++k) c[k] = (b4 ? a[k + 2] : a[k]) + __shfl_xor(b4 ? a[k] : a[k + 2], 16);
    float d = (b3 ? c[1] : c[0]) + __shfl_xor(b3 ? c[0] : c[1], 8);
    d += __shfl_xor(d, 4); d += __shfl_xor(d, 2); d += __shfl_xor(d, 1);
#pragma unroll
    for (int q = 0; q < 8; ++q) s[q] = __int_as_float(__builtin_amdgcn_readlane(__float_as_int(d), q * 8));
}
__device__ void phase_normmix(const Params& p) {
    const int wid = threadIdx.x >> 6, lane = threadIdx.x & 63, nw = gridDim.x * 8;
    const bf16_t* Y = (const bf16_t*)(p.ws + WS_TMP);
    const bf16_t* proj = (const bf16_t*)(p.ws + WS_PROJ);
    bf16_t* MIX = (bf16_t*)(p.ws + WS_ABUF);
    float4 gn[8];
#pragma unroll
    for (int q = 0; q < 8; ++q) gn[q] = q < 4 ? *(const float4*)(p.ssm_norm_g + q * 256 + lane * 4) : *(const float4*)(p.ret_norm_g + (q - 4) * 256 + lane * 4);
    for (int row0 = blockIdx.x * 8 + wid; row0 < MOUT; row0 += 2 * nw) {
        float4 v[2][8]; u32x2 gg[2][4];
#pragma unroll
        for (int u = 0; u < 2; ++u) { const int row = row0 + u * nw;
            if (row < MOUT) { const bf16_t* y = Y + (size_t)row * DM;
#pragma unroll
                for (int q = 0; q < 8; ++q) v[u][q] = ld4bf(y + q * 256 + lane * 4);
#pragma unroll
                for (int q = 0; q < 4; ++q) gg[u][q] = *(const u32x2*)(proj + (size_t)row * PROJP + OG + q * 256 + lane * 4); } }
#pragma unroll
        for (int u = 0; u < 2; ++u) { const int row = row0 + u * nw;
            if (row < MOUT) {
                float ss[8];
#pragma unroll
                for (int q = 0; q < 8; ++q) ss[q] = v[u][q].x * v[u][q].x + v[u][q].y * v[u][q].y + v[u][q].z * v[u][q].z + v[u][q].w * v[u][q].w;
                wave_sum8(ss);
                float rs[8];
                rs[0] = rs[1] = rsqrtf((ss[0] + ss[1]) * (1.0f / 512.0f) + EPS);
                rs[2] = rs[3] = rsqrtf((ss[2] + ss[3]) * (1.0f / 512.0f) + EPS);
#pragma unroll
                for (int q = 4; q < 8; ++q) rs[q] = rsqrtf(ss[q] * (1.0f / 256.0f) + EPS);
#pragma unroll
                for (int q = 0; q < 8; ++q) {
                    const int col = q * 256 + lane * 4;
                    float4 g; float4 o; const float4 w4 = v[u][q];
                    if (q < 4) { g = gn[q]; o.x = w4.x * rs[q] * g.x; o.y = w4.y * rs[q] * g.y; o.z = w4.z * rs[q] * g.z; o.w = w4.w * rs[q] * g.w; }
                    else { g = gn[q];
                        const u32x2 gq = gg[u][q - 4];
                        o.x = w4.x * rs[q] * g.x * silu_f(lo16(gq.x)); o.y = w4.y * rs[q] * g.y * silu_f(hi16(gq.x));
                        o.z = w4.z * rs[q] * g.z * silu_f(lo16(gq.y)); o.w = w4.w * rs[q] * g.w * silu_f(hi16(gq.y)); }
                    u32x2 w; w.x = pack2(o.x, o.y); w.y = pack2(o.z, o.w);
                    *(u32x2*)(MIX + (size_t)row * DM + col) = w;
                }
            } }
    }
}

__device__ void phase_mid(const Params& p) {
    const int wid = threadIdx.x >> 6, lane = threadIdx.x & 63, nw = gridDim.x * 8;
    const bf16_t* T = (const bf16_t*)(p.ws + WS_TMP);
    bf16_t* H1 = (bf16_t*)(p.ws + WS_H1);
    bf16_t* F = (bf16_t*)(p.ws + WS_ABUF);
    float4 g1[8], g2[8];
#pragma unroll
    for (int q = 0; q < 8; ++q) { g1[q] = *(const float4*)(p.post_mix_g + q * 256 + lane * 4); g2[q] = *(const float4*)(p.pre_ffn_g + q * 256 + lane * 4); }
    for (int row = blockIdx.x * 8 + wid; row < MOUT; row += nw) {
        const bf16_t* t = T + (size_t)row * DM; const float* x = src_row(p, row);
        const float* t2 = (const float*)(p.ws + WS_AUX2) + (size_t)(row - SROW0) * DM;
        float4 v[8], hx[8]; float ss = 0.f;
#pragma unroll
        for (int q = 0; q < 8; ++q) { hx[q] = *(const float4*)(x + q * 256 + lane * 4);
            if (row >= SROW0) { const float4 a = *(const float4*)(t2 + q * 256 + lane * 4), w = *(const float4*)(t2 + (size_t)DECB * DM + q * 256 + lane * 4);
                v[q] = make_float4(a.x + w.x, a.y + w.y, a.z + w.z, a.w + w.w); }
            else v[q] = ld4bf(t + q * 256 + lane * 4); }
#pragma unroll
        for (int q = 0; q < 8; ++q) ss += v[q].x * v[q].x + v[q].y * v[q].y + v[q].z * v[q].z + v[q].w * v[q].w;
        ss = wave_sum(ss);
        const float rs = rsqrtf(ss * (1.0f / DM) + EPS);
        float ss2 = 0.f;
#pragma unroll
        for (int q = 0; q < 8; ++q) { const int col = q * 256 + lane * 4; const float4 g = g1[q]; const float4 h = hx[q];
            float4& w = v[q];
            w.x = h.x + w.x * rs * g.x; w.y = h.y + w.y * rs * g.y; w.z = h.z + w.z * rs * g.z; w.w = h.w + w.w * rs * g.w;
            { u32x2 hw; hw.x = pack2(w.x, w.y); hw.y = pack2(w.z, w.w); *(u32x2*)(H1 + (size_t)row * DM + col) = hw; }
            ss2 += w.x * w.x + w.y * w.y + w.z * w.z + w.w * w.w; }
        ss2 = wave_sum(ss2);
        const float rs2 = rsqrtf(ss2 * (1.0f / DM) + EPS);
#pragma unroll
        for (int q = 0; q < 8; ++q) { const int col = q * 256 + lane * 4; const float4 g = g2[q];
            u32x2 w; w.x = pack2(v[q].x * rs2 * g.x, v[q].y * rs2 * g.y); w.y = pack2(v[q].z * rs2 * g.z, v[q].w * rs2 * g.w);
            *(u32x2*)(F + (size_t)row * DM + col) = w; }
    }
}

__device__ void phase_final(const Params& p) {
    const int wid = threadIdx.x >> 6, lane = threadIdx.x & 63, nw = gridDim.x * 8;
    const bf16_t* T = (const bf16_t*)(p.ws + WS_TMP);
    const bf16_t* H1 = (const bf16_t*)(p.ws + WS_H1);
    float4 g1[8];
#pragma unroll
    for (int q = 0; q < 8; ++q) g1[q] = *(const float4*)(p.post_ffn_g + q * 256 + lane * 4);
    for (int row = blockIdx.x * 8 + wid; row < MOUT; row += nw) {
        float* o = row < MMAIN ? p.out + O_YP + (size_t)row * DM : p.out + O_YS + (size_t)(row - SROW0) * DM;
        const bf16_t* t = T + (size_t)row * DM; const bf16_t* h = H1 + (size_t)row * DM;
        const float* t2 = (const float*)(p.ws + WS_AUX2) + (size_t)(row - SROW0) * DM;
        float4 v[8], hx[8]; float ss = 0.f;
#pragma unroll
        for (int q = 0; q < 8; ++q) { hx[q] = ld4bf(h + q * 256 + lane * 4);
            if (row >= SROW0) { const float4 a = *(const float4*)(t2 + q * 256 + lane * 4), w = *(const float4*)(t2 + (size_t)DECB * DM + q * 256 + lane * 4);
                v[q] = make_float4(a.x + w.x, a.y + w.y, a.z + w.z, a.w + w.w); }
            else v[q] = ld4bf(t + q * 256 + lane * 4); }
#pragma unroll
        for (int q = 0; q < 8; ++q) ss += v[q].x * v[q].x + v[q].y * v[q].y + v[q].z * v[q].z + v[q].w * v[q].w;
        ss = wave_sum(ss);
        const float rs = rsqrtf(ss * (1.0f / DM) + EPS);
#pragma unroll
        for (int q = 0; q < 8; ++q) { const int col = q * 256 + lane * 4; const float4 g = g1[q]; const float4 hh = hx[q];
            float4 r; r.x = hh.x + v[q].x * rs * g.x; r.y = hh.y + v[q].y * rs * g.y; r.z = hh.z + v[q].z * rs * g.z; r.w = hh.w + v[q].w * rs * g.w;
            *(float4*)(o + col) = r; }
    }
}

__global__ void __launch_bounds__(512, 2) hymba_mega(Params p) {
    extern __shared__ __attribute__((aligned(16))) unsigned char shm[];
    LAS unsigned char* lds = (LAS unsigned char*)shm;
    cg::grid_group grid = cg::this_grid();
    volatile LAS unsigned* xst = (volatile LAS unsigned*)(lds + LDS_ST);
    if (threadIdx.x < 4) xst[threadIdx.x] = 0u;
    __syncthreads();
    const XcdBarrier xb = xcd_barrier_post((unsigned*)(p.ws + WS_BAR), xst);
#define PHASE(i) if (p.ph_lo <= (i) && (i) < p.ph_hi)
#define SEAM(i) do { if (p.ph_lo <= (i) && (i) + 1 < p.ph_hi) { if (p.coop == 1) xcd_barrier(xb); else if (p.coop == 2) grid.sync(); } } while (0)
    PHASE(0) phase_prep(p, lds);
    SEAM(0);
    PHASE(1) {
        pg8::Gemm g{(const bf16_t*)(p.ws + WS_ABUF), (const bf16_t*)(p.ws + WS_WIN), MPAD, PROJP, DM};
        pg8::StaticOrder S; S.init(MPAD, PROJP, gridDim.x, blockIdx.x);
        pg8::EpiBf16 E{(bf16_t*)(p.ws + WS_PROJ), PROJP};
        pg8::gemm_phase(lds, g, S, E);
        {
            const int G = gridDim.x, r = S.nwg % G, c = blockIdx.x;
            __syncthreads();
            if (r == 0) weights_pass(p, lds, WT0, WT3, c, G);
            else if (c >= r) weights_pass(p, lds, WT0, WT3, c - r, G - r);
        }
    }
    SEAM(1);
    PHASE(2) phase_convrope(p);
    SEAM(2);
    PHASE(3) phase_mixers(p, lds);
    SEAM(3);
    PHASE(4) phase_normmix(p);
    SEAM(4);
    PHASE(5) {
        pg8::Gemm g{(const bf16_t*)(p.ws + WS_ABUF), (const bf16_t*)(p.ws + WS_WOUT), MMAIN, DM, DM};
        pg8::StaticOrder S; S.init(MMAIN, DM, gridDim.x, blockIdx.x);
        pg8::EpiBf16 E{(bf16_t*)(p.ws + WS_TMP), DM};
        pg8::gemm_phase(lds, g, S, E);
        aux_gemm((const bf16_t*)(p.ws + WS_ABUF) + (size_t)SROW0 * DM, DM, (const bf16_t*)(p.ws + WS_WOUT), DM, (float*)(p.ws + WS_AUX2), (float*)(p.ws + WS_AUX2) + (size_t)DECB * DM);
    }
    SEAM(5);
    PHASE(6) phase_mid(p);
    SEAM(6);
    PHASE(7) {
        pg8::Gemm g{(const bf16_t*)(p.ws + WS_ABUF), (const bf16_t*)(p.ws + WS_WGU), MPAD, 2 * DFF, DM};
        pg8::StaticOrder S; S.init(MPAD, 2 * DFF, gridDim.x, blockIdx.x);
        pg8::EpiSwiGLU E{(bf16_t*)(p.ws + WS_PROJ), DFF};
        pg8::gemm_phase(lds, g, S, E);
        {
            const int G = gridDim.x, r = S.nwg % G, c = blockIdx.x;
            __syncthreads();
            if (r == 0) weights_pass(p, lds, WT3, WT4, c, G);
            else if (c >= r) weights_pass(p, lds, WT3, WT4, c - r, G - r);
        }
    }
    SEAM(7);
    PHASE(8) {
        pg8::Gemm g{(const bf16_t*)(p.ws + WS_PROJ), (const bf16_t*)(p.ws + WS_WDN), MMAIN, DM, DFF};
        pg8::StaticOrder S; S.init(MMAIN, DM, gridDim.x, blockIdx.x);
        pg8::EpiBf16 E{(bf16_t*)(p.ws + WS_TMP), DM};
        pg8::gemm_phase(lds, g, S, E);
        aux_gemm((const bf16_t*)(p.ws + WS_PROJ) + (size_t)SROW0 * DFF, DFF, (const bf16_t*)(p.ws + WS_WDN), DFF, (float*)(p.ws + WS_AUX2), (float*)(p.ws + WS_AUX2) + (size_t)DECB * DM);
    }
    SEAM(8);
    PHASE(9) phase_final(p);
#undef PHASE
#undef SEAM
}

extern "C" void kernel_launch(void* const* d_in, const int* in_sizes, int n_in, void* d_out, int out_size, void* d_ws, size_t ws_size, hipStream_t stream) {
    static int grid = 0;
    if (grid == 0) {
        if (n_in != 22 || (size_t)out_size != O_END || ws_size < WS_END) { fprintf(stderr, "kernel_launch: unexpected shapes (n_in %d out %d ws %zu need %zu)\n", n_in, out_size, ws_size, (size_t)WS_END); grid = -1; return; }
        int dev = 0, cus = 0, per_cu = 0;
        (void)hipGetDevice(&dev);
        (void)hipDeviceGetAttribute(&cus, hipDeviceAttributeMultiprocessorCount, dev);
        if (hipFuncSetAttribute((const void*)hymba_mega, hipFuncAttributeMaxDynamicSharedMemorySize, LDS_BYTES) != hipSuccess) { fprintf(stderr, "kernel_launch: hipFuncSetAttribute failed\n"); grid = -1; return; }
        if (hipOccupancyMaxActiveBlocksPerMultiprocessor(&per_cu, (const void*)hymba_mega, 512, LDS_BYTES) != hipSuccess || per_cu < 1) { fprintf(stderr, "kernel_launch: occupancy query gave %d\n", per_cu); per_cu = 1; }
        (void)hipGetLastError();
        grid = cus * 1;
        if (grid <= 0) grid = 256;
    }
    if (grid < 0) return;
    Params p;
    memset(&p, 0, sizeof(p));
    const float** f = (const float**)&p;
    for (int i = 0; i < 22; ++i) f[i] = (const float*)d_in[i];
    p.out = (float*)d_out; p.ws = (unsigned char*)d_ws;
    p.lg0 = (float)log1p(-exp2(-5.0)); p.lg1 = (float)log1p(-exp2(-6.0)); p.lg2 = (float)log1p(-exp2(-7.0)); p.lg3 = (float)log1p(-exp2(-8.0));
    if (hipMemsetAsync((char*)d_ws + WS_BAR, 0, 16384, stream) != hipSuccess) { fprintf(stderr, "kernel_launch: memset of barrier words failed\n"); return; }
#if COOP_LAUNCH
    p.ph_lo = 0; p.ph_hi = NPHASE; p.coop = 1;
    void* args[] = {&p};
    hipError_t e = hipLaunchCooperativeKernel((const void*)hymba_mega, dim3(grid), dim3(512), args, LDS_BYTES, stream);
    if (e != hipSuccess) fprintf(stderr, "cooperative launch failed: %s (grid %d)\n", hipGetErrorString(e), grid);
#else
    for (int ph = 0; ph < NPHASE; ++ph) {
        p.ph_lo = ph; p.ph_hi = ph + 1; p.coop = 0;
        hipLaunchKernelGGL(hymba_mega, dim3(grid), dim3(512), LDS_BYTES, stream, p);
    }
#endif
}
```
